# Optimizing an MI355X kernel written in HIP

```python
import jax, jax.numpy as jnp
from jax import lax
import numpy as np

D_MODEL = 1024
BATCH = 1
SEQ = 16384
DEPTH = 1

MLA_HEADS = 8
MLA_Q_RANK = 384
MLA_KV_RANK = 256
MLA_NOPE = 128
MLA_ROPE = 64
MLA_V = 128
MLA_WIDTH = MLA_HEADS * MLA_V
RET_HEADS = 4
RET_QK = 256
RET_V = 512
RET_WIDTH = RET_HEADS * RET_V
RET_CHUNK = 128
ATTN_BLOCK = 128
ROPE_THETA = 10000.0
EPS = 1e-6
IN_SIZES = (MLA_Q_RANK, MLA_KV_RANK, MLA_ROPE, MLA_WIDTH,
            RET_HEADS * RET_QK, RET_HEADS * RET_QK, RET_WIDTH, RET_WIDTH,
            D_MODEL, D_MODEL)
IN_TOTAL = 384 + 256 + 64 + 1024 + 1024 + 1024 + 2048 + 2048 + 1024 + 1024

kernel_name = "hybrid_mla_retention_gated_block"


def _split_points():
    pts, acc = [], 0
    for s in IN_SIZES[:-1]:
        acc += s
        pts.append(acc)
    return pts


def rmsnorm(x, g):
    xf = x.astype(jnp.float32)
    r = xf * lax.rsqrt(jnp.mean(xf * xf, axis=-1, keepdims=True) + EPS)
    return (r * g.astype(jnp.float32)).astype(x.dtype)


def rotary(x, positions):
    d = x.shape[-1]
    inv_freq = ROPE_THETA ** (-jnp.arange(0, d, 2, dtype=jnp.float32) / d)
    ang = positions.astype(jnp.float32)[..., None] * inv_freq
    cos = jnp.cos(ang)[:, :, None, :]
    sin = jnp.sin(ang)[:, :, None, :]
    xf = x.astype(jnp.float32)
    x1, x2 = xf[..., : d // 2], xf[..., d // 2:]
    out = jnp.concatenate([x1 * cos - x2 * sin, x2 * cos + x1 * sin], axis=-1)
    return out.astype(x.dtype)


def causal_block_attention(q, k, v):
    B, S, H, Dh = q.shape
    nb = S // ATTN_BLOCK
    scale = Dh ** -0.5
    qb = q.reshape(B, nb, ATTN_BLOCK, H, Dh).transpose(1, 0, 3, 2, 4)
    k_idx = jnp.arange(S)

    def one_block(args):
        qi, i = args
        s = jnp.einsum('bhqd,bkhd->bhqk', qi, k, preferred_element_type=jnp.float32) * scale
        q_idx = i * ATTN_BLOCK + jnp.arange(ATTN_BLOCK)
        mask = k_idx[None, :] <= q_idx[:, None]
        s = jnp.where(mask[None, None], s, -1e30)
        p = jax.nn.softmax(s, axis=-1).astype(v.dtype)
        return jnp.einsum('bhqk,bkhd->bqhd', p, v)

    out = lax.map(one_block, (qb, jnp.arange(nb)))
    return out.transpose(1, 0, 2, 3, 4).reshape(B, S, H, v.shape[-1])


def mla_branch(c_q, c_kv, k_pe, positions, g_q, w_q_up, g_kv, w_kv_up):
    B, S, _ = c_q.shape
    q = (rmsnorm(c_q, g_q) @ w_q_up).reshape(B, S, MLA_HEADS, MLA_NOPE + MLA_ROPE)
    q = jnp.concatenate([q[..., :MLA_NOPE], rotary(q[..., MLA_NOPE:], positions)], axis=-1)
    kv = (rmsnorm(c_kv, g_kv) @ w_kv_up).reshape(B, S, MLA_HEADS, MLA_NOPE + MLA_V)
    k_nope, v = kv[..., :MLA_NOPE], kv[..., MLA_NOPE:]
    k_rope = rotary(k_pe[:, :, None, :], positions)
    k = jnp.concatenate([k_nope, jnp.broadcast_to(k_rope, (B, S, MLA_HEADS, MLA_ROPE))], axis=-1)
    return causal_block_attention(q, k, v).reshape(B, S, MLA_WIDTH)


def retention_branch(q, k, v, positions, g_ret):
    B, S, _ = q.shape
    H, C = RET_HEADS, RET_CHUNK
    n = S // C
    q = rotary(q.reshape(B, S, H, RET_QK), positions)
    k = rotary(k.reshape(B, S, H, RET_QK), positions) * (RET_QK ** -0.5)
    v = v.reshape(B, S, H, RET_V)
    log_gamma = jnp.log1p(-jnp.exp2(-5.0 - jnp.arange(H, dtype=jnp.float32)))
    idx = jnp.arange(C, dtype=jnp.float32)
    diff = idx[:, None] - idx[None, :]
    decay_in = jnp.where(diff >= 0, jnp.exp(log_gamma[:, None, None] * jnp.maximum(diff, 0.0)), 0.0)
    xi = jnp.exp(log_gamma[:, None] * (idx + 1.0))
    zeta = jnp.exp(log_gamma[:, None] * (C - 1.0 - idx))
    gamma_c = jnp.exp(log_gamma * C)

    def to_chunks(t):
        return t.reshape(B, n, C, H, t.shape[-1]).transpose(1, 0, 3, 2, 4).astype(jnp.float32)

    def step(R, chunk):
        qc, kc, vc = chunk
        inner = jnp.einsum('bhqk,bhkd->bhqd', jnp.einsum('bhqd,bhkd->bhqk', qc, kc) * decay_in[None], vc)
        cross = jnp.einsum('bhqd,bhde->bhqe', qc, R) * xi[None, :, :, None]
        R = R * gamma_c[None, :, None, None] + jnp.einsum('bhkd,bhke->bhde', kc * zeta[None, :, :, None], vc)
        return R, inner + cross

    R0 = jnp.zeros((B, H, RET_QK, RET_V), jnp.float32)
    _, out = lax.scan(step, R0, (to_chunks(q), to_chunks(k), to_chunks(v)))
    out = out.transpose(1, 0, 3, 2, 4).reshape(B, S, H, RET_V)
    mu = jnp.mean(out, axis=-1, keepdims=True)
    var = jnp.mean(jnp.square(out - mu), axis=-1, keepdims=True)
    out = ((out - mu) * lax.rsqrt(var + EPS)).reshape(B, S, RET_WIDTH) * g_ret.astype(jnp.float32)
    return out.astype(q.dtype)


def setup_inputs(seed: int = 0) -> dict:
    key = jax.random.key(seed)
    ks = jax.random.split(key, 17)
    f32 = jnp.float32

    def w(k, shape, fan_in):
        return jax.random.normal(k, shape, f32) * (fan_in ** -0.5)

    def gain(k, shape):
        return 1.0 + 0.02 * jax.random.normal(k, shape, f32)

    x = jax.random.normal(ks[0], (BATCH, SEQ, D_MODEL), f32)
    c = jax.random.normal(ks[1], (BATCH, D_MODEL), f32)
    positions = (jnp.arange(SEQ, dtype=jnp.int32)[None, :]
                 + jax.random.randint(ks[2], (BATCH, 1), 0, 1024, dtype=jnp.int32))
    return {
        "x": x,
        "c": c,
        "positions": positions,
        "w_ada": w(ks[3], (DEPTH, D_MODEL, 3 * D_MODEL), D_MODEL),
        "b_ada": 0.02 * jax.random.normal(ks[4], (DEPTH, 3 * D_MODEL), f32),
        "g_pre": gain(ks[5], (DEPTH, D_MODEL)),
        "w_in": w(ks[6], (DEPTH, D_MODEL, IN_TOTAL), D_MODEL),
        "g_q": gain(ks[7], (DEPTH, MLA_Q_RANK)),
        "w_q_up": w(ks[8], (DEPTH, MLA_Q_RANK, MLA_HEADS * (MLA_NOPE + MLA_ROPE)), MLA_Q_RANK),
        "g_kv": gain(ks[9], (DEPTH, MLA_KV_RANK)),
        "w_kv_up": w(ks[10], (DEPTH, MLA_KV_RANK, MLA_HEADS * (MLA_NOPE + MLA_V)), MLA_KV_RANK),
        "g_ret": gain(ks[11], (DEPTH, RET_WIDTH)),
        "w_proj_mla": w(ks[12], (DEPTH, MLA_WIDTH, D_MODEL), MLA_WIDTH),
        "w_proj_ret": w(ks[13], (DEPTH, RET_WIDTH, D_MODEL), RET_WIDTH),
        "w_out": w(ks[14], (DEPTH, D_MODEL, D_MODEL), D_MODEL),
        "g_final": gain(ks[15], (D_MODEL,)),
    }


def reference(x, c, positions, w_ada, b_ada, g_pre, w_in, g_q, w_q_up, g_kv, w_kv_up,
              g_ret, w_proj_mla, w_proj_ret, w_out, g_final):
    pts = _split_points()
    for l in range(DEPTH):
        mod = jax.nn.silu(c) @ w_ada[l] + b_ada[l]
        shift, scale, gate = jnp.split(mod[:, None, :], 3, axis=-1)
        h = rmsnorm(x, g_pre[l]) * (1.0 + scale) + shift
        proj = h @ w_in[l]
        (c_q, c_kv, k_pe, gate_mla, q_ret, k_ret, v_ret, gate_ret,
         merge_mla, merge_ret) = jnp.split(proj, pts, axis=-1)
        y_mla = mla_branch(c_q, c_kv, k_pe, positions, g_q[l], w_q_up[l], g_kv[l], w_kv_up[l])
        y_mla = y_mla * jax.nn.silu(gate_mla)
        y_ret = retention_branch(q_ret, k_ret, v_ret, positions, g_ret[l]) * jax.nn.silu(gate_ret)
        merged = (jax.nn.sigmoid(merge_mla) * (y_mla @ w_proj_mla[l])
                  + jax.nn.sigmoid(merge_ret) * (y_ret @ w_proj_ret[l]))
        x = x + gate * (merged @ w_out[l])
    return rmsnorm(x, g_final)
```

```cpp
#include <hip/hip_runtime.h>
#include <cstdio>
#include <cstdint>

#define GAS __attribute__((address_space(1)))
#define LAS __attribute__((address_space(3)))
typedef unsigned short bf16_t;
typedef short bf16x8 __attribute__((ext_vector_type(8)));
typedef short s16x4 __attribute__((ext_vector_type(4)));
typedef float f32x4 __attribute__((ext_vector_type(4)));
typedef float f32x2 __attribute__((ext_vector_type(2)));
typedef float f32x16 __attribute__((ext_vector_type(16)));
typedef unsigned u32x4 __attribute__((ext_vector_type(4)));
typedef unsigned u32x2 __attribute__((ext_vector_type(2)));
typedef GAS unsigned gu32;

constexpr int SEQ = 16384, DM = 1024;
constexpr int NWAVES = 8, NTHR = 512;
constexpr float EPS = 1e-6f;
constexpr int NWIN = 9984;
constexpr int WT_QRET = 0, WT_KRET = 4, WT_VRET = 8, WT_GRET = 16, WT_GMLA = 24, WT_MMLA = 28, WT_MRET = 32, WT_LOW = 36;

constexpr size_t MiB = 1u << 20;
constexpr size_t WS_CTL = 0, CTL_ZERO_BYTES = 64 * 1024;
constexpr size_t WS_MODP = 128 * 1024;
constexpr size_t WS_MOD = 512 * 1024;
constexpr size_t WS_FSQ = 1 * MiB;
constexpr size_t WS_PSQ = 2 * MiB;
constexpr size_t WS_STAT = 4 * MiB;
constexpr size_t WS_WIN = 8 * MiB;
constexpr size_t WS_WQ = 28 * MiB;
constexpr size_t WS_WKV = 30 * MiB;
constexpr size_t WS_WPM = 31 * MiB;
constexpr size_t WS_WPR = 33 * MiB;
constexpr size_t WS_WO = 37 * MiB;
constexpr size_t WS_H = 40 * MiB;
constexpr size_t WS_X = 72 * MiB;
constexpr size_t WS_AQ = WS_X;
constexpr size_t WS_VRH = WS_X + 64 * MiB;
constexpr size_t WS_KZT = WS_X + 128 * MiB;
constexpr size_t WS_CQ = WS_X + 160 * MiB;
constexpr size_t WS_CKV = WS_X + 172 * MiB;
constexpr size_t WS_KROPE = WS_X + 180 * MiB;
constexpr size_t WS_Q = WS_X + 24 * MiB;
constexpr size_t WS_K = WS_X + 72 * MiB;
constexpr size_t WS_V = WS_X + 120 * MiB;
constexpr size_t WS_O = WS_X + 152 * MiB;
constexpr size_t WS_SCRA = WS_X;
constexpr size_t WS_SCRB = WS_X + 32 * MiB;
constexpr size_t WS_MERGED = WS_X + 96 * MiB;
constexpr size_t WS_END = 256 * MiB;

constexpr int CW_BAR = 4096;
constexpr int CW_CNT = 8192;
constexpr int CW_PANEL = 12288;
constexpr int CW_ADONE = 2816;
constexpr int CW_WAR = 2560;
constexpr int CW_GEMV = 2048;
constexpr int CW_AFLAG = 3072;

constexpr int RING_BYTES = 131072;
constexpr int LDSCTL_OFF = RING_BYTES, MISC_OFF = LDSCTL_OFF + 320;
constexpr int LDS_BYTES = 147456;

#define RLX_AGENT __ATOMIC_RELAXED, __HIP_MEMORY_SCOPE_AGENT
#define LDS_WAIT() asm volatile("s_waitcnt lgkmcnt(0)" ::: "memory")
#define VM_WAIT() asm volatile("s_waitcnt vmcnt(0)" ::: "memory")
__device__ __forceinline__ unsigned f2bf(float f) { unsigned u = __builtin_bit_cast(unsigned, f); return (u + 0x7fffu + ((u >> 16) & 1u)) >> 16; }
__device__ __forceinline__ unsigned pk2(float lo, float hi) { return f2bf(lo) | (f2bf(hi) << 16); }
__device__ __forceinline__ float bf2f(unsigned short b) { return __builtin_bit_cast(float, ((unsigned)b) << 16); }
__device__ __forceinline__ float bflo(unsigned w) { return __builtin_bit_cast(float, w << 16); }
__device__ __forceinline__ float bfhi(unsigned w) { return __builtin_bit_cast(float, w & 0xffff0000u); }
typedef __bf16 bf16x2_t __attribute__((ext_vector_type(2)));
__device__ __forceinline__ unsigned cvt_pk_bf16(float lo, float hi) { f32x2 v = {lo, hi}; bf16x2_t b = __builtin_convertvector(v, bf16x2_t); return __builtin_bit_cast(unsigned, b); }
__device__ __forceinline__ float fast_exp2(float x) { return __builtin_amdgcn_exp2f(x); }
__device__ __forceinline__ float fast_rcp(float x) { return __builtin_amdgcn_rcpf(x); }
__device__ __forceinline__ float sigmoidf_(float x) { return fast_rcp(1.0f + fast_exp2(-1.4426950408889634f * x)); }
__device__ __forceinline__ float siluf_(float x) { return x * sigmoidf_(x); }
__device__ __forceinline__ void sincos_ang(float ang, float& s, float& c) {
    const float hi = 0.15915493667125702f, lo = 6.420638326565253e-09f;
    const float p = ang * hi; float e = __builtin_fmaf(ang, hi, -p); e = __builtin_fmaf(ang, lo, e);
    const float f = (p - __builtin_rintf(p)) + e;
    s = __builtin_amdgcn_sinf(f); c = __builtin_amdgcn_cosf(f);
}
__device__ __forceinline__ float wave_sum(float v) {
#pragma unroll
    for (int o = 1; o < 64; o <<= 1) v += __shfl_xor(v, o);
    return v;
}
__device__ const float INVF[128] = { 1.000000000e+00f, 9.305720329e-01f, 8.659643531e-01f, 8.058421612e-01f, 7.498942018e-01f, 6.978305578e-01f, 6.493816376e-01f, 6.042963862e-01f, 5.623413324e-01f, 5.232990980e-01f, 4.869675338e-01f, 4.531583786e-01f, 4.216965139e-01f, 3.924189806e-01f, 3.651741147e-01f, 3.398208320e-01f, 3.162277639e-01f, 2.942727208e-01f, 2.738419771e-01f, 2.548296750e-01f, 2.371373773e-01f, 2.206734121e-01f, 2.053525001e-01f, 1.910952926e-01f, 1.778279394e-01f, 1.654817164e-01f, 1.539926529e-01f, 1.433012635e-01f, 1.333521456e-01f, 1.240937784e-01f, 1.154781953e-01f, 1.074607819e-01f, 1.000000015e-01f, 9.305720776e-02f, 8.659642935e-02f, 8.058422059e-02f, 7.498942316e-02f, 6.978306174e-02f, 6.493816525e-02f, 6.042964011e-02f, 5.623413250e-02f, 5.232991278e-02f, 4.869675264e-02f, 4.531583562e-02f, 4.216964915e-02f, 3.924189880e-02f, 3.651741147e-02f, 3.398208320e-02f, 3.162277490e-02f, 2.942727134e-02f, 2.738419548e-02f, 2.548296750e-02f, 2.371373773e-02f, 2.206734009e-02f, 2.053525113e-02f, 1.910953037e-02f, 1.778279431e-02f, 1.654817164e-02f, 1.539926510e-02f, 1.433012541e-02f, 1.333521400e-02f, 1.240937784e-02f, 1.154781971e-02f, 1.074607857e-02f, 9.999999776e-03f, 9.305720218e-03f, 8.659643121e-03f, 8.058422245e-03f, 7.498942316e-03f, 6.978305988e-03f, 6.493816152e-03f, 6.042963825e-03f, 5.623413250e-03f, 5.232991185e-03f, 4.869675264e-03f, 4.531583749e-03f, 4.216964822e-03f, 3.924189601e-03f, 3.651741194e-03f, 3.398208413e-03f, 3.162277630e-03f, 2.942727180e-03f, 2.738419687e-03f, 2.548296703e-03f, 2.371373819e-03f, 2.206734149e-03f, 2.053525066e-03f, 1.910952968e-03f, 1.778279431e-03f, 1.654817141e-03f, 1.539926510e-03f, 1.433012541e-03f, 1.333521446e-03f, 1.240937738e-03f, 1.154782018e-03f, 1.074607833e-03f, 1.000000047e-03f, 9.305720450e-04f, 8.659643354e-04f, 8.058421663e-04f, 7.498941850e-04f, 6.978305755e-04f, 6.493816036e-04f, 6.042963942e-04f, 5.623413017e-04f, 5.232990952e-04f, 4.869675322e-04f, 4.531583691e-04f, 4.216965172e-04f, 3.924189659e-04f, 3.651741135e-04f, 3.398208355e-04f, 3.162277571e-04f, 2.942727297e-04f, 2.738419571e-04f, 2.548296761e-04f, 2.371373703e-04f, 2.206734061e-04f, 2.053525095e-04f, 1.910952997e-04f, 1.778279402e-04f, 1.654817170e-04f, 1.539926598e-04f, 1.433012512e-04f, 1.333521504e-04f, 1.240937709e-04f, 1.154782003e-04f, 1.074607862e-04f };
__device__ __forceinline__ float l2gamma(int h) { return h == 0 ? -0.04580368961312479f : h == 1 ? -0.02272007650008353f : h == 2 ? -0.011315313227834146f : -0.005646563141142063f; }

#define XB_TMO      128
#define XB_XCNT(j)  (256  + 64 * (j))
#define XB_XSUB(j)  (1280 + 64 * (j))
#define XB_XGEN(j)  (2304 + 64 * (j))
#define XB_TOP      3328
#define XB_TOPGEN   3392
#define XCD_BAR_WORDS 3456
#define XB_SPIN_CAP (1u << 18)
__device__ __forceinline__ unsigned xb_ld(unsigned* p)              { return __hip_atomic_load(p, __ATOMIC_RELAXED, __HIP_MEMORY_SCOPE_AGENT); }
__device__ __forceinline__ unsigned xb_add(unsigned* p, unsigned v) { return __hip_atomic_fetch_add(p, v, __ATOMIC_RELAXED, __HIP_MEMORY_SCOPE_AGENT); }
__device__ __forceinline__ unsigned xb_xcc_id() { return (unsigned)__builtin_amdgcn_s_getreg((3 << 11) | 20) & 0xFu; }
#define XB_SPIN(cond, bar) do { unsigned _sp = 0; while (cond) { __builtin_amdgcn_s_sleep(1); \
    if ((++_sp & 255u) == 0u) { if (xb_ld(&(bar)[XB_TMO])) break; if (_sp > XB_SPIN_CAP) { atomicAdd(&(bar)[XB_TMO], 1u); break; } } } } while (0)
struct XcdBarrier { unsigned* bar; unsigned x; volatile LAS unsigned* st; };
__device__ __forceinline__ XcdBarrier xcd_barrier_post(unsigned* bar, volatile LAS unsigned* st) {
    XcdBarrier b; b.bar = bar; b.x = xb_xcc_id(); b.st = st;
    if (threadIdx.x == 0) (void)xb_add(&bar[XB_XCNT(b.x)], 1u);
    return b;
}
__device__ __forceinline__ void xcd_barrier_complete(unsigned* bar, unsigned x, unsigned& nloc, unsigned& nx) {
    const unsigned G = gridDim.x * gridDim.y * gridDim.z;
    unsigned sum, cnt, mine, sp = 0u;
    for (;;) {
        sum = 0u; cnt = 0u; mine = 0u;
#pragma unroll
        for (unsigned j = 0; j < 16; ++j) { const unsigned c = xb_ld(&bar[XB_XCNT(j)]); sum += c; cnt += (c > 0u) ? 1u : 0u; mine = (j == x) ? c : mine; }
        if (sum == G) break;
        __builtin_amdgcn_s_sleep(1);
        if ((++sp & 255u) == 0u) { if (xb_ld(&bar[XB_TMO])) break; if (sp > XB_SPIN_CAP) { atomicAdd(&bar[XB_TMO], 1u); break; } }
    }
    nloc = mine > 0u ? mine : 1u; nx = cnt > 0u ? cnt : 1u;
}
__device__ __forceinline__ void xcd_barrier(const XcdBarrier& b) {
    asm volatile("s_waitcnt vmcnt(0)" ::: "memory");
    __syncthreads();
    if (threadIdx.x == 0) {
        unsigned* bar = b.bar;
        __builtin_amdgcn_s_waitcnt(0);
        unsigned nloc = b.st[0], nx = b.st[1];
        if (nloc == 0u) { xcd_barrier_complete(bar, b.x, nloc, nx); b.st[0] = nloc; b.st[1] = nx; }
        const unsigned old = xb_add(&bar[XB_XSUB(b.x)], 1u);
        const unsigned gen = old / nloc;
        if (old + 1u == (gen + 1u) * nloc) {
            __builtin_amdgcn_fence(__ATOMIC_RELEASE, "agent");
            asm volatile("s_waitcnt vmcnt(0)" ::: "memory");
            const unsigned og = xb_add(&bar[XB_TOP], 1u);
            const unsigned tg = og / nx;
            if (og + 1u == (tg + 1u) * nx) xb_add(&bar[XB_TOPGEN], 1u);
            else XB_SPIN(xb_ld(&bar[XB_TOPGEN]) == tg, bar);
            __builtin_amdgcn_fence(__ATOMIC_ACQUIRE, "agent");
            xb_add(&bar[XB_XGEN(b.x)], 1u);
            asm volatile("s_waitcnt vmcnt(0)" ::: "memory");
        } else {
            XB_SPIN(xb_ld(&bar[XB_XGEN(b.x)]) == gen, bar);
            __builtin_amdgcn_fence(__ATOMIC_ACQUIRE, "agent");
            asm volatile("s_waitcnt vmcnt(0)" ::: "memory");
        }
    }
    __syncthreads();
}

struct Ctx {
    float* out; unsigned char* ws;
    int tid, lane, wave, vcu, G;
};
enum InIdx { I_X = 0, I_C, I_POS, I_WADA, I_BADA, I_GPRE, I_WIN, I_GQ, I_WQUP, I_GKV, I_WKVUP, I_GRET, I_WPM, I_WPR, I_WOUT, I_GFINAL };
constexpr int PTR_OFF = LDSCTL_OFF;
__device__ __forceinline__ const void* inptr_raw(int k) {
    const volatile LAS unsigned* p = (const volatile LAS unsigned*)(size_t)(PTR_OFF + 8 * k);
    const unsigned lo = (unsigned)__builtin_amdgcn_readfirstlane((int)p[0]), hi = (unsigned)__builtin_amdgcn_readfirstlane((int)p[1]);
    return (const void*)(const GAS char*)(((unsigned long long)hi << 32) | lo);
}
#define INF(k) ((const float*)inptr_raw(k))
#define INI(k) ((const int*)inptr_raw(k))

enum Kind { K_QK = 0, K_TRANS, K_S, K_U, K_MAIN, K_LOW, K_QUP, K_KVUP, K_GMLA, K_GRET, K_P0, K_P1, K_P2, K_P3, K_FINAL };
struct GCall { int kind, NO, K, lda, ldb, hf, nk; };
struct Unit { int t, o; };
constexpr int BK = 64, HALF = 128, HTB = HALF * BK * 2;
constexpr float QSCALE = 0.07216878364870322f * 1.4426950408889634f;

__host__ __device__ __forceinline__ int lds_byte(int r, int c) { const int st = (r >> 4) * 2 + (c >> 5), rr = r & 15, cc = c & 31, ob = rr * 64 + cc * 2; return st * 1024 + (ob ^ (((ob >> 9) & 1) << 5)); }
__host__ __device__ __forceinline__ void stage_rc(int b, int& R, int& C) { const int st = b / 1024, sb = b % 1024, swz = sb ^ (((sb >> 9) & 1) << 5); R = (st >> 1) * 16 + swz / 64; C = (st & 1) * 32 + (swz % 64) / 2; }
__host__ __device__ __forceinline__ int perm32(int rho) { const int n = rho >> 4, i = rho & 15; return 8 * (i >> 2) + 4 * n + (i & 3); }

__device__ __forceinline__ bool unit_next(const GCall& g, int vcu, int i, Unit& u) {
    const int x = vcu >> 5, l = vcu & 31; u.t = 8 * x + (l & 7);
    if (g.kind == K_GRET) { u.o = 2 * (l >> 3) + i; return i < 2; }
    if (g.kind == K_KVUP) { const int q4 = l >> 3; if (q4 < 2) { u.o = q4; return i < 1; } u.o = q4 + 2 * i; return i < 3; }
    u.o = 4 * i + (l >> 3); return u.o < g.NO;
}
__device__ __forceinline__ void unit_ptrs(const GCall& g, const Ctx& X, const Unit& u, const char*& A, const char*& B) {
    size_t z_ = 0; asm volatile("" : "+s"(z_)); const unsigned char* wsb = X.ws + z_; const float* outb = X.out + z_;
    const bf16_t* a = nullptr; const bf16_t* b = nullptr;
    const bf16_t* Hb = (const bf16_t*)(wsb + WS_H); const bf16_t* Win = (const bf16_t*)(wsb + WS_WIN);
    const size_t t = (size_t)u.t, o = (size_t)u.o;
    switch (g.kind) {
    case K_QK:    a = Hb + t * 256 * 1024; b = Win + o * 256 * 1024; break;
    case K_TRANS: { const size_t rt = (u.o < g.nk) ? (size_t)(WT_KRET + u.o) : (size_t)(WT_VRET + (u.o - g.nk) * 2 + g.hf); a = Win + rt * 256 * 1024; b = Hb + t * 256 * 1024; } break;
    case K_S:     a = (const bf16_t*)(wsb + WS_AQ) + (o * SEQ + t * 256) * 512 + 256; b = (const bf16_t*)outb + (o * SEQ + t * 256) * 256; break;
    case K_U:     a = (const bf16_t*)(wsb + WS_VRH) + ((o * 256) * 64 + t) * 512; b = (const bf16_t*)(wsb + WS_KZT) + (o * 256) * (size_t)SEQ + t * 256; break;
    case K_MAIN:  a = (const bf16_t*)(wsb + WS_AQ) + (o * SEQ + t * 256) * 512; b = (const bf16_t*)(wsb + WS_VRH) + ((o * 256) * 64 + t) * 512; break;
    case K_LOW:   a = Hb + t * 256 * 1024; b = Win + (WT_LOW + o) * 256 * 1024; break;
    case K_QUP:   a = (const bf16_t*)(wsb + WS_CQ) + t * 256 * 384; b = (const bf16_t*)(wsb + WS_WQ) + o * 256 * 384; break;
    case K_KVUP:  a = (const bf16_t*)(wsb + WS_CKV) + t * 256 * 256; b = (const bf16_t*)(wsb + WS_WKV) + o * 256 * 256; break;
    case K_GMLA:  a = Hb + t * 256 * 1024; b = Win + (WT_GMLA + o) * 256 * 1024; break;
    case K_GRET:  a = Hb + t * 256 * 1024; b = Win + (WT_GRET + o) * 256 * 1024; break;
    case K_P0:    a = Hb + t * 256 * 1024; b = Win + (WT_MMLA + o) * 256 * 1024; break;
    case K_P1:    a = (const bf16_t*)(wsb + WS_O) + t * 256 * 1024; b = (const bf16_t*)(wsb + WS_WPM) + o * 256 * 1024; break;
    case K_P2:    a = Hb + t * 256 * 1024; b = Win + (WT_MRET + o) * 256 * 1024; break;
    case K_P3:    a = (const bf16_t*)outb + t * 256 * 2048; b = (const bf16_t*)(wsb + WS_WPR) + o * 256 * 2048; break;
    default:      a = (const bf16_t*)(wsb + WS_MERGED) + t * 256 * 1024; b = (const bf16_t*)(wsb + WS_WO) + o * 256 * 1024; break;
    }
    A = (const char*)a; B = (const char*)b;
}

__device__ __forceinline__ u32x4 pack8f(const f32x4 a, const f32x4 b) { u32x4 w; w.x = cvt_pk_bf16(a[0], a[1]); w.y = cvt_pk_bf16(a[2], a[3]); w.z = cvt_pk_bf16(b[0], b[1]); w.w = cvt_pk_bf16(b[2], b[3]); return w; }
__device__ __forceinline__ void unpack8(const u32x4 w, f32x4& a, f32x4& b) { a[0] = bflo(w.x); a[1] = bfhi(w.x); a[2] = bflo(w.y); a[3] = bfhi(w.y); b[0] = bflo(w.z); b[1] = bfhi(w.z); b[2] = bflo(w.w); b[3] = bfhi(w.w); }

struct EpiP { int kind, hf, nk; };
#define PIN8(a) asm volatile("" : "+v"(a[0]), "+v"(a[1]), "+v"(a[2]), "+v"(a[3]), "+v"(a[4]), "+v"(a[5]), "+v"(a[6]), "+v"(a[7]))
__device__ __forceinline__ void epilogue(const GCall& g0, const Ctx& X0, f32x4 (&acc)[2][2][4][2], const Unit& u, int wr, int wc, int fr, int fq) {
    size_t z_ = 0; asm volatile("" : "+s"(z_));
    struct { unsigned char* ws; float* out; } X = {X0.ws + z_, X0.out + z_}; EpiP g = {g0.kind, g0.hf, g0.nk};
    asm volatile("" : "+s"(g.kind), "+s"(g.hf), "+s"(g.nk), "+s"(wr), "+s"(wc), "+v"(fr), "+v"(fq));
    const int t = u.t, o = u.o;
    const int* const posp = INI(I_POS);
    const int cl0 = 32 * wc + 8 * fq;
    const int rl0 = 64 * wr + fr;
    switch (g.kind) {
    case K_QK: {
        const int h = o & 3; const bool isk = o >= 4; const float l2g = l2gamma(h);
        float invf[8];
#pragma unroll
        for (int j = 0; j < 8; ++j) invf[j] = INVF[cl0 + j];
        PIN8(invf);
        bf16_t* dst = isk ? ((bf16_t*)X.out + (size_t)h * SEQ * 256) : ((bf16_t*)(X.ws + WS_AQ) + (size_t)h * SEQ * 512 + 256);
        const int pitch = isk ? 256 : 512;
        int posv[2][4];
#pragma unroll
        for (int ai = 0; ai < 2; ++ai)
#pragma unroll
            for (int m = 0; m < 4; ++m) posv[ai][m] = posp[256 * t + 128 * ai + 16 * m + rl0];
#pragma unroll
        for (int ai = 0; ai < 2; ++ai)
#pragma unroll
            for (int m = 0; m < 4; ++m) {
                const int rl = 128 * ai + 16 * m + rl0, tok = 256 * t + rl;
                const float posf = (float)posv[ai][m];
                const float sc = isk ? 0.0625f * fast_exp2((float)(255 - rl) * l2g) : 1.0f;
                f32x4 o1[2], o2[2];
#pragma unroll
                for (int n = 0; n < 2; ++n)
#pragma unroll
                    for (int j = 0; j < 4; ++j) { float s, c; sincos_ang(posf * invf[4 * n + j], s, c); const float x1 = acc[ai][0][m][n][j], x2 = acc[ai][1][m][n][j];
                        o1[n][j] = (x1 * c - x2 * s) * sc; o2[n][j] = (x2 * c + x1 * s) * sc; }
                bf16_t* p = dst + (size_t)tok * pitch + cl0;
                *(u32x4*)p = pack8f(o1[0], o1[1]); *(u32x4*)(p + 128) = pack8f(o2[0], o2[1]);
                if (isk) {
                    bf16_t* kzt = (bf16_t*)(X.ws + WS_KZT) + (size_t)h * 256 * SEQ; const bool odd = fr & 1; const int tokp = tok & ~1;
#pragma unroll
                    for (int hb = 0; hb < 2; ++hb)
#pragma unroll
                        for (int n = 0; n < 2; ++n)
#pragma unroll
                            for (int j = 0; j < 4; j += 2) { const float a = hb ? o2[n][j] : o1[n][j], b = hb ? o2[n][j + 1] : o1[n][j + 1];
                                const float recv = __shfl_xor(odd ? a : b, 1);
                                const int d = 128 * hb + cl0 + 4 * n + j + (odd ? 1 : 0);
                                *(unsigned*)(kzt + (size_t)d * SEQ + tokp) = odd ? cvt_pk_bf16(recv, b) : cvt_pk_bf16(a, recv); }
                }
            }
    } break;
    case K_TRANS: {
        {
            const int hh = o - g.nk; bf16_t* dst = (bf16_t*)(X.ws + WS_VRH);
#pragma unroll
            for (int ai = 0; ai < 2; ++ai)
#pragma unroll
                for (int m = 0; m < 4; ++m) { const int e = 128 * ai + 16 * m + rl0; bf16_t* p = dst + ((size_t)(hh * 256 + e) * 64 + t) * 512 + cl0;
#pragma unroll
                    for (int bj = 0; bj < 2; ++bj) *(u32x4*)(p + 128 * bj) = pack8f(acc[ai][bj][m][0], acc[ai][bj][m][1]); }
        }
    } break;
    case K_S: {
        const int h = o; const float ginv = fast_exp2(-256.0f * l2gamma(h));
        bf16_t* dst = (bf16_t*)(X.ws + WS_AQ) + ((size_t)h * SEQ + 256 * t) * 512;
#pragma unroll
        for (int ai = 0; ai < 2; ++ai)
#pragma unroll
            for (int m = 0; m < 4; ++m) { const int i = 128 * ai + 16 * m + rl0;
#pragma unroll
                for (int bj = 0; bj < 2; ++bj) { const int j0 = 128 * bj + cl0; f32x4 v[2];
#pragma unroll
                    for (int n = 0; n < 2; ++n)
#pragma unroll
                        for (int j = 0; j < 4; ++j) v[n][j] = (j0 + 4 * n + j <= i) ? acc[ai][bj][m][n][j] * ginv : 0.0f;
                    *(u32x4*)(dst + (size_t)i * 512 + j0) = pack8f(v[0], v[1]); } }
    } break;
    case K_U: {
        const int h = o; bf16_t* dst = (bf16_t*)(X.ws + WS_VRH);
#pragma unroll
        for (int ai = 0; ai < 2; ++ai)
#pragma unroll
            for (int m = 0; m < 4; ++m) { const int e = 128 * ai + 16 * m + rl0; bf16_t* p = dst + ((size_t)(h * 256 + e) * 64 + t) * 512 + 256 + cl0;
#pragma unroll
                for (int bj = 0; bj < 2; ++bj) *(u32x4*)(p + 128 * bj) = pack8f(acc[ai][bj][m][0], acc[ai][bj][m][1]); }
    } break;
    case K_MAIN: {
        const int h = o; const float l2g = l2gamma(h);
        bf16_t* dst = (bf16_t*)X.out; f32x2* stat = (f32x2*)(X.ws + WS_STAT);
#pragma unroll
        for (int ai = 0; ai < 2; ++ai)
#pragma unroll
            for (int m = 0; m < 4; ++m) { const int i = 128 * ai + 16 * m + rl0, tok = 256 * t + i; const float xi = fast_exp2((float)(i + 1) * l2g);
                float s = 0.f, ss = 0.f;
#pragma unroll
                for (int bj = 0; bj < 2; ++bj) { f32x4 v0 = acc[ai][bj][m][0] * xi, v1 = acc[ai][bj][m][1] * xi;
#pragma unroll
                    for (int j = 0; j < 4; ++j) { s += v0[j] + v1[j]; ss += v0[j] * v0[j] + v1[j] * v1[j]; }
                    *(u32x4*)(dst + (size_t)tok * 2048 + h * 512 + g.hf * 256 + 128 * bj + cl0) = pack8f(v0, v1); }
                s += __shfl_xor(s, 16); s += __shfl_xor(s, 32); ss += __shfl_xor(ss, 16); ss += __shfl_xor(ss, 32);
                if (fq == 0) stat[(((size_t)tok * 4 + h) * 2 + g.hf) * 4 + wc] = (f32x2){s, ss};
            }
        if (g.hf == 1 && (wr | wc | fr | fq) == 0) __hip_atomic_fetch_add((unsigned*)(X.ws + WS_CTL) + CW_WAR, 1u, __ATOMIC_RELAXED, __HIP_MEMORY_SCOPE_AGENT);
    } break;
    case K_LOW: {
        bf16_t* CQ = (bf16_t*)(X.ws + WS_CQ); bf16_t* CKV = (bf16_t*)(X.ws + WS_CKV); bf16_t* KR = (bf16_t*)(X.ws + WS_KROPE); float* psq = (float*)(X.ws + WS_PSQ);
        int posv[2][4]; float fv[4];
        { const bool pe = (o == 2) && (cl0 < 64);
#pragma unroll
          for (int jj = 0; jj < 4; ++jj) fv[jj] = INVF[4 * (((cl0 & 63) >> 1) + jj)];
#pragma unroll
          for (int ai = 0; ai < 2; ++ai)
#pragma unroll
              for (int m = 0; m < 4; ++m) posv[ai][m] = pe ? posp[256 * t + 128 * ai + 16 * m + rl0] : 0;
          asm volatile("" : "+v"(fv[0]), "+v"(fv[1]), "+v"(fv[2]), "+v"(fv[3]), "+v"(posv[0][0]), "+v"(posv[0][1]), "+v"(posv[0][2]), "+v"(posv[0][3]), "+v"(posv[1][0]), "+v"(posv[1][1]), "+v"(posv[1][2]), "+v"(posv[1][3])); }
#pragma unroll
        for (int ai = 0; ai < 2; ++ai)
#pragma unroll
            for (int m = 0; m < 4; ++m) { const int tok = 256 * t + 128 * ai + 16 * m + rl0;
#pragma unroll
                for (int bj = 0; bj < 2; ++bj) { const int gcol = 256 * o + 128 * bj + cl0; const f32x4 v0 = acc[ai][bj][m][0], v1 = acc[ai][bj][m][1];
                    if (gcol < 640) {
                        float ss = 0.f;
#pragma unroll
                        for (int j = 0; j < 4; ++j) ss += v0[j] * v0[j] + v1[j] * v1[j];
                        ss += __shfl_xor(ss, 16); ss += __shfl_xor(ss, 32);
                        if (fq == 0) psq[(size_t)tok * 24 + (gcol >> 5)] = ss;
                        bf16_t* p = (gcol < 384) ? (CQ + (size_t)tok * 384 + gcol) : (CKV + (size_t)tok * 256 + (gcol - 384));
                        *(u32x4*)p = pack8f(v0, v1);
                    } else if (gcol < 704) {
                        const int i0 = (gcol - 640) >> 1; const float posf = (float)posv[ai][m]; f32x4 o1, o2;
#pragma unroll
                        for (int jj = 0; jj < 4; ++jj) { const float x1 = jj < 2 ? v0[2 * jj] : v1[2 * jj - 4], x2 = jj < 2 ? v0[2 * jj + 1] : v1[2 * jj - 3];
                            float s, c; sincos_ang(posf * fv[jj], s, c); o1[jj] = x1 * c - x2 * s; o2[jj] = x2 * c + x1 * s; }
                        u32x2 w1, w2; w1.x = cvt_pk_bf16(o1[0], o1[1]); w1.y = cvt_pk_bf16(o1[2], o1[3]); w2.x = cvt_pk_bf16(o2[0], o2[1]); w2.y = cvt_pk_bf16(o2[2], o2[3]);
                        *(u32x2*)(KR + (size_t)tok * 64 + i0) = w1; *(u32x2*)(KR + (size_t)tok * 64 + 32 + i0) = w2;
                    }
                } }
    } break;
    case K_QUP: {
        bf16_t* Q = (bf16_t*)(X.ws + WS_Q); const float* psq = (const float*)(X.ws + WS_PSQ);
        float fv[8];
#pragma unroll
        for (int j = 0; j < 8; ++j) fv[j] = INVF[4 * (8 * fq + j)];
        int posv[8];
#pragma unroll
        for (int q = 0; q < 8; ++q) posv[q] = (o >= 4) ? posp[256 * t + 128 * (q >> 2) + 16 * (q & 3) + rl0] : 0;
        PIN8(fv); PIN8(posv);
#pragma unroll
        for (int ai = 0; ai < 2; ++ai) {
            f32x4 sv[4][3];
#pragma unroll
            for (int m = 0; m < 4; ++m) { const int tok = 256 * t + 128 * ai + 16 * m + rl0; const f32x4* sp = (const f32x4*)(psq + (size_t)tok * 24);
                sv[m][0] = sp[0]; sv[m][1] = sp[1]; sv[m][2] = sp[2]; }
#pragma unroll
            for (int m = 0; m < 4; ++m) { const int tok = 256 * t + 128 * ai + 16 * m + rl0; const f32x4 s0 = sv[m][0], s1 = sv[m][1], s2 = sv[m][2];
                const float ssum = ((s0[0] + s0[1]) + (s0[2] + s0[3])) + ((s1[0] + s1[1]) + (s1[2] + s1[3])) + ((s2[0] + s2[1]) + (s2[2] + s2[3]));
                const float rs = __builtin_amdgcn_rsqf(ssum * (1.0f / 384.0f) + EPS) * QSCALE;
                if (o < 4) {
#pragma unroll
                    for (int bj = 0; bj < 2; ++bj) *(u32x4*)(Q + (size_t)tok * 1536 + (2 * o + bj) * 192 + cl0) = pack8f(acc[ai][bj][m][0] * rs, acc[ai][bj][m][1] * rs);
                } else {
                    const int head = (o - 4) * 4 + wc, i0 = 8 * fq; const float posf = (float)posv[4 * ai + m]; f32x4 o1[2], o2[2];
#pragma unroll
                    for (int n = 0; n < 2; ++n)
#pragma unroll
                        for (int j = 0; j < 4; ++j) { float s, c; sincos_ang(posf * fv[4 * n + j], s, c); const float x1 = acc[ai][0][m][n][j] * rs, x2 = acc[ai][1][m][n][j] * rs;
                            o1[n][j] = x1 * c - x2 * s; o2[n][j] = x2 * c + x1 * s; }
                    bf16_t* p = Q + (size_t)tok * 1536 + head * 192 + 128 + i0;
                    *(u32x4*)p = pack8f(o1[0], o1[1]); *(u32x4*)(p + 32) = pack8f(o2[0], o2[1]);
                }
            }
        }
    } break;
    case K_KVUP: {
        bf16_t* Kb = (bf16_t*)(X.ws + WS_K); bf16_t* Vb = (bf16_t*)(X.ws + WS_V); const float* psq = (const float*)(X.ws + WS_PSQ);
        const int tid = (wr * 4 + wc) * 64 + fq * 16 + fr, tokc = 256 * t + (tid >> 1), hsel = tid & 1;
        const u32x4* src = (const u32x4*)((const bf16_t*)(X.ws + WS_KROPE) + (size_t)tokc * 64 + hsel * 32);
        u32x4 rp[4];
#pragma unroll
        for (int q = 0; q < 4; ++q) rp[q] = src[q];
#pragma unroll
        for (int ai = 0; ai < 2; ++ai) {
            f32x4 sv[4][2];
#pragma unroll
            for (int m = 0; m < 4; ++m) { const int tok = 256 * t + 128 * ai + 16 * m + rl0; sv[m][0] = *(const f32x4*)(psq + (size_t)tok * 24 + 12); sv[m][1] = *(const f32x4*)(psq + (size_t)tok * 24 + 16); }
            if (ai == 0) { u32x4* dstp = (u32x4*)(Kb + (size_t)tokc * 1536 + o * 192 + 128 + hsel * 32);
#pragma unroll
                for (int q = 0; q < 4; ++q) dstp[q] = rp[q]; }
#pragma unroll
            for (int m = 0; m < 4; ++m) { const int tok = 256 * t + 128 * ai + 16 * m + rl0; const f32x4 s0 = sv[m][0], s1 = sv[m][1];
                const float ssum = ((s0[0] + s0[1]) + (s0[2] + s0[3])) + ((s1[0] + s1[1]) + (s1[2] + s1[3]));
                const float rs = __builtin_amdgcn_rsqf(ssum * (1.0f / 256.0f) + EPS);
                *(u32x4*)(Kb + (size_t)tok * 1536 + o * 192 + cl0) = pack8f(acc[ai][0][m][0] * rs, acc[ai][0][m][1] * rs);
                *(u32x4*)(Vb + (size_t)tok * 1024 + o * 128 + cl0) = pack8f(acc[ai][1][m][0] * rs, acc[ai][1][m][1] * rs);
            }
        }
    } break;
    case K_GMLA: {
        bf16_t* Ob = (bf16_t*)(X.ws + WS_O);
#pragma unroll
        for (int ai = 0; ai < 2; ++ai) {
            u32x4 ov[4][2];
#pragma unroll
            for (int m = 0; m < 4; ++m)
#pragma unroll
                for (int bj = 0; bj < 2; ++bj) ov[m][bj] = *(const u32x4*)(Ob + (size_t)(256 * t + 128 * ai + 16 * m + rl0) * 1024 + 256 * o + 128 * bj + cl0);
#pragma unroll
            for (int m = 0; m < 4; ++m) { const int tok = 256 * t + 128 * ai + 16 * m + rl0;
#pragma unroll
                for (int bj = 0; bj < 2; ++bj) { bf16_t* p = Ob + (size_t)tok * 1024 + 256 * o + 128 * bj + cl0; f32x4 a, b; unpack8(ov[m][bj], a, b);
#pragma unroll
                    for (int j = 0; j < 4; ++j) { a[j] *= siluf_(acc[ai][bj][m][0][j]); b[j] *= siluf_(acc[ai][bj][m][1][j]); }
                    *(u32x4*)p = pack8f(a, b); } }
        }
        if ((wr | wc) == 0) { const unsigned* ad = (const unsigned*)(X.ws + WS_CTL) + CW_ADONE; unsigned sp = 0;
            while ((unsigned)__builtin_amdgcn_readfirstlane((int)__hip_atomic_load(ad, __ATOMIC_RELAXED, __HIP_MEMORY_SCOPE_AGENT)) < 256u) { __builtin_amdgcn_s_sleep(4); if (++sp > (1u << 22)) break; } }
    } break;
    case K_GRET: {
        const float* const g_retp = INF(I_GRET);
        bf16_t* Ob = (bf16_t*)X.out; const float* stat = (const float*)(X.ws + WS_STAT); const int h = o >> 1;
        f32x4 gv[2][2];
#pragma unroll
        for (int bj = 0; bj < 2; ++bj) { gv[bj][0] = *(const f32x4*)(g_retp + 256 * o + 128 * bj + cl0); gv[bj][1] = *(const f32x4*)(g_retp + 256 * o + 128 * bj + cl0 + 4); }
#pragma unroll
        for (int ai = 0; ai < 2; ++ai)
#pragma unroll
            for (int mp = 0; mp < 2; ++mp) {
                f32x4 sq[2][4]; u32x4 ov[2][2];
#pragma unroll
                for (int mm = 0; mm < 2; ++mm) { const int tok = 256 * t + 128 * ai + 16 * (2 * mp + mm) + rl0; const f32x4* sp = (const f32x4*)(stat + ((size_t)tok * 4 + h) * 16);
                    sq[mm][0] = sp[0]; sq[mm][1] = sp[1]; sq[mm][2] = sp[2]; sq[mm][3] = sp[3];
#pragma unroll
                    for (int bj = 0; bj < 2; ++bj) ov[mm][bj] = *(const u32x4*)(Ob + (size_t)tok * 2048 + 256 * o + 128 * bj + cl0); }
#pragma unroll
                for (int mm = 0; mm < 2; ++mm) { const int m = 2 * mp + mm, tok = 256 * t + 128 * ai + 16 * m + rl0; const f32x4 q0 = sq[mm][0], q1 = sq[mm][1], q2 = sq[mm][2], q3 = sq[mm][3];
                    const float s = ((q0[0] + q0[2]) + (q1[0] + q1[2])) + ((q2[0] + q2[2]) + (q3[0] + q3[2])), ss = ((q0[1] + q0[3]) + (q1[1] + q1[3])) + ((q2[1] + q2[3]) + (q3[1] + q3[3]));
                    const float mean = s * (1.0f / 512.0f); const float var = __builtin_fmaxf(ss * (1.0f / 512.0f) - mean * mean, 0.0f); const float rstd = __builtin_amdgcn_rsqf(var + EPS);
#pragma unroll
                    for (int bj = 0; bj < 2; ++bj) { bf16_t* p = Ob + (size_t)tok * 2048 + 256 * o + 128 * bj + cl0; f32x4 a, b; unpack8(ov[mm][bj], a, b);
#pragma unroll
                        for (int j = 0; j < 4; ++j) { a[j] = (a[j] - mean) * rstd * gv[bj][0][j] * siluf_(acc[ai][bj][m][0][j]); b[j] = (b[j] - mean) * rstd * gv[bj][1][j] * siluf_(acc[ai][bj][m][1][j]); }
                        *(u32x4*)p = pack8f(a, b); } }
            }
    } break;
    case K_P0: case K_P2: case K_P1: case K_P3: {
        const int tid = (wr * 4 + wc) * 64 + fq * 16 + fr;
        u32x2* sa = (u32x2*)(X.ws + WS_SCRA) + (size_t)blockIdx.x * 32 * 512 + tid; u32x2* sb = (u32x2*)(X.ws + WS_SCRB) + (size_t)blockIdx.x * 32 * 512 + tid;
        bf16_t* Mg = (bf16_t*)(X.ws + WS_MERGED);
        if (g.kind == K_P0 || g.kind == K_P2) {
#pragma unroll
            for (int ai = 0; ai < 2; ++ai)
#pragma unroll
                for (int bj = 0; bj < 2; ++bj)
#pragma unroll
                    for (int m = 0; m < 4; ++m)
#pragma unroll
                        for (int n = 0; n < 2; ++n) { const int ri = ((ai * 2 + bj) * 4 + m) * 2 + n; const f32x4 a = acc[ai][bj][m][n];
                            u32x2 w; w.x = cvt_pk_bf16(sigmoidf_(a[0]), sigmoidf_(a[1])); w.y = cvt_pk_bf16(sigmoidf_(a[2]), sigmoidf_(a[3])); sa[(size_t)ri * 512] = w; }
        } else {
#pragma unroll
            for (int ai = 0; ai < 2; ++ai)
#pragma unroll
                for (int bj = 0; bj < 2; ++bj) {
                    unsigned long long gw[4][2]; u32x2 tv[4][2];
#pragma unroll
                    for (int m = 0; m < 4; ++m)
#pragma unroll
                        for (int n = 0; n < 2; ++n) { const int ri = ((ai * 2 + bj) * 4 + m) * 2 + n;
                            gw[m][n] = __hip_atomic_load((const unsigned long long*)(sa + (size_t)ri * 512), __ATOMIC_RELAXED, __HIP_MEMORY_SCOPE_AGENT);
                            if (g.kind == K_P3) tv[m][n] = sb[(size_t)ri * 512]; }
#pragma unroll
                    for (int m = 0; m < 4; ++m) { f32x4 mv[2];
#pragma unroll
                        for (int n = 0; n < 2; ++n) { const int ri = ((ai * 2 + bj) * 4 + m) * 2 + n; const f32x4 a = acc[ai][bj][m][n];
                            const unsigned wx = (unsigned)gw[m][n], wy = (unsigned)(gw[m][n] >> 32); const f32x4 gt = {bflo(wx), bfhi(wx), bflo(wy), bfhi(wy)};
                            if (g.kind == K_P1) { const f32x4 pr = gt * a; u32x2 w; w.x = cvt_pk_bf16(pr[0], pr[1]); w.y = cvt_pk_bf16(pr[2], pr[3]); sb[(size_t)ri * 512] = w; }
                            else { const u32x2 w = tv[m][n]; mv[n] = (f32x4){bflo(w.x), bfhi(w.x), bflo(w.y), bfhi(w.y)} + gt * a; } }
                        if (g.kind == K_P3) { const int tok = 256 * t + 128 * ai + 16 * m + rl0; *(u32x4*)(Mg + (size_t)tok * 1024 + 256 * o + 128 * bj + cl0) = pack8f(mv[0], mv[1]); } }
                }
        }
    } break;
    default: break;
    }
}

__device__ __forceinline__ void epilogue_final(const Ctx& X0, f32x4 (&acc)[2][2][4][2], const Unit& u, int wr, int wc, int fr, int fq, LAS unsigned char* lds) {
    size_t z_ = 0; asm volatile("" : "+s"(z_));
    struct { unsigned char* ws; float* out; } X = {X0.ws + z_, X0.out + z_};
    asm volatile("" : "+s"(wr), "+s"(wc), "+v"(fr), "+v"(fq));
    const int t = u.t, o = u.o, cl0 = 32 * wc + 8 * fq, rl0 = 64 * wr + fr, tid = (wr * 4 + wc) * 64 + fq * 16 + fr;
    const float* const xp = INF(I_X);
    const float* gate = (const float*)(X.ws + WS_MOD) + 2048; float* fsq = (float*)(X.ws + WS_FSQ);
    unsigned* cnt = (unsigned*)(X.ws + WS_CTL) + CW_CNT + 64 * t;
    LAS u32x2* slot = (LAS u32x2*)lds + tid;
    { f32x4 gv[2][2];
#pragma unroll
    for (int bj = 0; bj < 2; ++bj) { gv[bj][0] = *(const f32x4*)(gate + 256 * o + 128 * bj + cl0); gv[bj][1] = *(const f32x4*)(gate + 256 * o + 128 * bj + cl0 + 4); }
    f32x4 xv[2][2][2][2];
#define XLOAD(b_) do { _Pragma("unroll") for (int mm = 0; mm < 2; ++mm) _Pragma("unroll") for (int bj = 0; bj < 2; ++bj) _Pragma("unroll") for (int n = 0; n < 2; ++n) \
        xv[(b_) & 1][mm][bj][n] = *(const f32x4*)(xp + (size_t)(256 * t + 128 * ((b_) >> 1) + 16 * (2 * ((b_) & 1) + mm) + rl0) * 1024 + 256 * o + 128 * bj + cl0 + 4 * n); } while (0)
    XLOAD(0);
#pragma unroll
    for (int b = 0; b < 4; ++b) { const int ai = b >> 1, mp = b & 1;
        if (b + 1 < 4) XLOAD(b + 1);
#pragma unroll
        for (int mm = 0; mm < 2; ++mm) { const int m = 2 * mp + mm, tok = 256 * t + 128 * ai + 16 * m + rl0; float ss = 0.f;
#pragma unroll
            for (int bj = 0; bj < 2; ++bj)
#pragma unroll
                for (int n = 0; n < 2; ++n) {
                    const f32x4 v = xv[b & 1][mm][bj][n] + gv[bj][n] * acc[ai][bj][m][n]; u32x2 w; w.x = cvt_pk_bf16(v[0], v[1]); w.y = cvt_pk_bf16(v[2], v[3]);
                    const f32x4 vr = {bflo(w.x), bfhi(w.x), bflo(w.y), bfhi(w.y)};
                    ss += (vr[0] * vr[0] + vr[1] * vr[1]) + (vr[2] * vr[2] + vr[3] * vr[3]); slot[(((ai * 2 + bj) * 4 + m) * 2 + n) * 512] = w; }
            ss += __shfl_xor(ss, 16); ss += __shfl_xor(ss, 32);
            if (fq == 0) __hip_atomic_store(fsq + (size_t)tok * 16 + 4 * o + wc, ss, __ATOMIC_RELAXED, __HIP_MEMORY_SCOPE_AGENT); } }
#undef XLOAD
    }
    asm volatile("s_waitcnt vmcnt(0)" ::: "memory");
    if (fq == 0 && fr == 0) __hip_atomic_fetch_add(cnt, 1u, __ATOMIC_RELAXED, __HIP_MEMORY_SCOPE_AGENT);
    { unsigned sp = 0;
      while ((unsigned)__builtin_amdgcn_readfirstlane((int)__hip_atomic_load(cnt, __ATOMIC_RELAXED, __HIP_MEMORY_SCOPE_AGENT)) < 32u) { __builtin_amdgcn_s_sleep(4); if (++sp > (1u << 22)) break; } }
    __builtin_amdgcn_fence(__ATOMIC_ACQUIRE, "agent");
    { const float* const gfin = INF(I_GFINAL);
    f32x4 gf[2][2];
#pragma unroll
    for (int bj = 0; bj < 2; ++bj) { gf[bj][0] = *(const f32x4*)(gfin + 256 * o + 128 * bj + cl0); gf[bj][1] = *(const f32x4*)(gfin + 256 * o + 128 * bj + cl0 + 4); }
    float rstd[2][4];
    { f32x4 fv[2][4][4];
#pragma unroll
      for (int ai = 0; ai < 2; ++ai)
#pragma unroll
          for (int m = 0; m < 4; ++m) { const f32x4* sp = (const f32x4*)(fsq + (size_t)(256 * t + 128 * ai + 16 * m + rl0) * 16); fv[ai][m][0] = sp[0]; fv[ai][m][1] = sp[1]; fv[ai][m][2] = sp[2]; fv[ai][m][3] = sp[3]; }
#pragma unroll
      for (int ai = 0; ai < 2; ++ai)
#pragma unroll
          for (int m = 0; m < 4; ++m) { const f32x4 a = fv[ai][m][0], b = fv[ai][m][1], c = fv[ai][m][2], d = fv[ai][m][3];
              const float ss = (((a[0] + a[1]) + (a[2] + a[3])) + ((b[0] + b[1]) + (b[2] + b[3]))) + (((c[0] + c[1]) + (c[2] + c[3])) + ((d[0] + d[1]) + (d[2] + d[3])));
              rstd[ai][m] = __builtin_amdgcn_rsqf(ss * (1.0f / DM) + EPS); } }
#pragma unroll
    for (int ai = 0; ai < 2; ++ai)
#pragma unroll
        for (int m = 0; m < 4; ++m) { const int tok = 256 * t + 128 * ai + 16 * m + rl0;
#pragma unroll
            for (int bj = 0; bj < 2; ++bj)
#pragma unroll
                for (int n = 0; n < 2; ++n) { const u32x2 w = slot[(((ai * 2 + bj) * 4 + m) * 2 + n) * 512]; const f32x4 v = {bflo(w.x), bfhi(w.x), bflo(w.y), bfhi(w.y)};
                    *(f32x4*)(X.out + (size_t)tok * 1024 + 256 * o + 128 * bj + cl0 + 4 * n) = v * rstd[ai][m] * gf[bj][n]; }
            asm volatile("" ::: "memory"); } }
}

struct Step;
__device__ __forceinline__ GCall step_call(int si);
__device__ __forceinline__ void gemm_stream(LAS unsigned char* lds, int s0, int ns, const Ctx& X) {
    const int tid = X.tid, wid = __builtin_amdgcn_readfirstlane(tid >> 6), lane = tid & 63, wr = wid >> 2, wc = wid & 3, fr = lane & 15, fq = lane >> 4;
#define PG8_VOFF(VA, VB, lda_, ldb_) do { int t_ = tid; asm volatile("" : "+v"(t_)); _Pragma("unroll") for (int i = 0; i < 2; ++i) { int R_, C_; stage_rc(t_ * 16 + i * 8192, R_, C_); \
        const int Rb_ = (R_ & ~31) + perm32(R_ & 31); VA[i] = (unsigned)(R_ * (lda_) + C_) * 2u; VB[i] = (unsigned)(Rb_ * (ldb_) + C_) * 2u; } } while (0)
    const size_t kstep = (size_t)(BK * 2);
    const unsigned ldsw = (unsigned)wid * 1024u;
    const int aoff = lds_byte(wr * 64 + fr, fq * 8), boff = lds_byte(wc * 32 + fr, fq * 8);
#define PG8_SA(b, h) (((b) * 2 + (h)) * HTB)
#define PG8_SB(b, h) ((4 + (b) * 2 + (h)) * HTB)
#define PG8_STAGE(bufoff, gbase, voff) do { _Pragma("unroll") for (int _i = 0; _i < 2; ++_i) \
        __builtin_amdgcn_global_load_lds((const unsigned*)((const char*)(gbase) + (voff)[_i]), (LAS unsigned*)(lds + (bufoff) + ldsw + _i * 8192), 16, 0, 0); } while (0)
#define PG8_LDA(dst, b, h) do { _Pragma("unroll") for (int m = 0; m < 4; ++m) _Pragma("unroll") for (int k = 0; k < 2; ++k) dst[m][k] = *(const LAS bf16x8*)(lds + PG8_SA(b, h) + aoff + m * 2048 + k * 1024); } while (0)
#define PG8_LDB(dst, b, h) do { _Pragma("unroll") for (int n = 0; n < 2; ++n) _Pragma("unroll") for (int k = 0; k < 2; ++k) dst[n][k] = *(const LAS bf16x8*)(lds + PG8_SB(b, h) + boff + n * 2048 + k * 1024); } while (0)
#define PG8_MMA(ai, bj, At, Bt) do { __builtin_amdgcn_s_setprio(1); _Pragma("unroll") for (int m = 0; m < 4; ++m) _Pragma("unroll") for (int n = 0; n < 2; ++n) _Pragma("unroll") for (int k = 0; k < 2; ++k) \
        acc[ai][bj][m][n] = __builtin_amdgcn_mfma_f32_16x16x32_bf16(Bt[n][k], At[m][k], acc[ai][bj][m][n], 0, 0, 0); __builtin_amdgcn_s_setprio(0); } while (0)
#define PG8_WAIT_V(n) asm volatile("s_waitcnt vmcnt(" #n ")" ::: "memory")
#define PG8_WAIT_L(n) asm volatile("s_waitcnt lgkmcnt(" #n ")" ::: "memory")
#define PG8_BAR __builtin_amdgcn_s_barrier()
#define PG8_SCHED __builtin_amdgcn_sched_barrier(0)
#define PG8_KBODY(a1, a2, a3, b2, b3, VA2, VB2, HA2, HB2) do { \
        PG8_LDB(B0, 0, 0); PG8_LDB(B1, 0, 1); PG8_SCHED; PG8_LDA(At, 0, 0); PG8_STAGE(PG8_SA(1, 1), (a1) + hstepA, voffA); \
        PG8_WAIT_V(8); PG8_WAIT_L(0); PG8_BAR; PG8_MMA(0, 0, At, B0); PG8_MMA(0, 1, At, B1); PG8_BAR; PG8_SCHED; \
        PG8_LDA(At, 0, 1); PG8_STAGE(PG8_SB(0, 0), (b2), VB2); PG8_STAGE(PG8_SB(0, 1), (b2) + (HB2), VB2); PG8_STAGE(PG8_SA(0, 0), (a2), VA2); \
        PG8_WAIT_V(8); PG8_WAIT_L(0); PG8_BAR; PG8_MMA(1, 0, At, B0); PG8_MMA(1, 1, At, B1); PG8_BAR; PG8_SCHED; \
        PG8_LDB(B0, 1, 0); PG8_LDB(B1, 1, 1); PG8_SCHED; PG8_LDA(At, 1, 0); PG8_STAGE(PG8_SA(0, 1), (a2) + (HA2), VA2); \
        PG8_WAIT_V(8); PG8_WAIT_L(0); PG8_BAR; PG8_MMA(0, 0, At, B0); PG8_MMA(0, 1, At, B1); PG8_BAR; PG8_SCHED; \
        PG8_LDA(At, 1, 1); PG8_STAGE(PG8_SB(1, 0), (b3), VB2); PG8_STAGE(PG8_SB(1, 1), (b3) + (HB2), VB2); PG8_STAGE(PG8_SA(1, 0), (a3), VA2); \
        PG8_WAIT_V(8); PG8_WAIT_L(0); PG8_BAR; PG8_MMA(1, 0, At, B0); PG8_MMA(1, 1, At, B1); PG8_BAR; PG8_SCHED; } while (0)
    int seg = 0, ui = 0; GCall g = step_call(s0); Unit cur;
    while (!unit_next(g, X.vcu, ui, cur)) { if (++seg >= ns) return; g = step_call(s0 + seg); ui = 0; }
    unsigned voffA[2], voffB[2], nvoffA[2], nvoffB[2];
    PG8_VOFF(voffA, voffB, g.lda, g.ldb);
    size_t hstepA = (size_t)HALF * g.lda * 2, hstepB = (size_t)HALF * g.ldb * 2;
    int nt = g.K / BK;
    f32x4 acc[2][2][4][2];
#pragma unroll
    for (int a = 0; a < 2; ++a)
#pragma unroll
        for (int b = 0; b < 2; ++b)
#pragma unroll
            for (int m = 0; m < 4; ++m)
#pragma unroll
                for (int n = 0; n < 2; ++n) acc[a][b][m][n] = (f32x4){0.f, 0.f, 0.f, 0.f};
    bf16x8 At[4][2], B0[2][2], B1[2][2];
    const char* cA; const char* cB; unit_ptrs(g, X, cur, cA, cB);
    PG8_STAGE(PG8_SB(0, 0), cB, voffB); PG8_STAGE(PG8_SB(0, 1), cB + hstepB, voffB); PG8_STAGE(PG8_SA(0, 0), cA, voffA); PG8_STAGE(PG8_SA(0, 1), cA + hstepA, voffA);
    if (wr == 1) PG8_BAR;
    PG8_WAIT_V(2); PG8_BAR;
    PG8_STAGE(PG8_SB(1, 0), cB + kstep, voffB); PG8_STAGE(PG8_SA(1, 0), cA + kstep, voffA); PG8_STAGE(PG8_SB(1, 1), cB + hstepB + kstep, voffB);
    PG8_WAIT_V(6); PG8_BAR;
    for (;;) {
        GCall ng = g; Unit nxt; int nseg = seg, nui = ui + 1; bool has_next = true;
        while (!unit_next(ng, X.vcu, nui, nxt)) { if (++nseg >= ns) { has_next = false; break; } ng = step_call(s0 + nseg); nui = 0; }
        const char* nA = cA; const char* nB = cB; size_t nhstepA = hstepA, nhstepB = hstepB;
#pragma unroll
        for (int i = 0; i < 2; ++i) { nvoffA[i] = voffA[i]; nvoffB[i] = voffB[i]; }
        if (has_next) { unit_ptrs(ng, X, nxt, nA, nB); nhstepA = (size_t)HALF * ng.lda * 2; nhstepB = (size_t)HALF * ng.ldb * 2;
            if (nseg != seg) PG8_VOFF(nvoffA, nvoffB, ng.lda, ng.ldb); }
        for (int t = 0; t < nt - 2; t += 2) {
            const char* a1 = cA + (size_t)(t + 1) * kstep; const char* a2 = cA + (size_t)(t + 2) * kstep; const char* b2 = cB + (size_t)(t + 2) * kstep;
            PG8_KBODY(a1, a2, a2 + kstep, b2, b2 + kstep, voffA, voffB, hstepA, hstepB);
        }
        { const char* a1 = cA + (size_t)(nt - 1) * kstep;
          PG8_KBODY(a1, nA, nA + kstep, nB, nB + kstep, nvoffA, nvoffB, nhstepA, nhstepB); }
        if (wr == 0) PG8_BAR;
        if (g.kind != K_FINAL) epilogue(g, X, acc, cur, wr, wc, fr, fq);
        if (!has_next) break;
#pragma unroll
        for (int a = 0; a < 2; ++a)
#pragma unroll
            for (int b = 0; b < 2; ++b)
#pragma unroll
                for (int m = 0; m < 4; ++m)
#pragma unroll
                    for (int n = 0; n < 2; ++n) acc[a][b][m][n] = (f32x4){0.f, 0.f, 0.f, 0.f};
        cur = nxt; cA = nA; cB = nB; g = ng; seg = nseg; ui = nui; hstepA = nhstepA; hstepB = nhstepB; nt = g.K / BK;
#pragma unroll
        for (int i = 0; i < 2; ++i) { voffA[i] = nvoffA[i]; voffB[i] = nvoffB[i]; }
        if (wr == 1) PG8_BAR;
    }
    PG8_WAIT_V(0);
    PG8_BAR;
    if (g.kind == K_FINAL) epilogue_final(X, acc, cur, wr, wc, fr, fq, lds);
#undef PG8_KBODY
#undef PG8_VOFF
#undef PG8_SA
#undef PG8_SB
#undef PG8_STAGE
#undef PG8_LDA
#undef PG8_LDB
#undef PG8_MMA
#undef PG8_WAIT_V
#undef PG8_WAIT_L
#undef PG8_BAR
#undef PG8_SCHED
}

namespace att16 {
constexpr int QP = 1536, VP = 1024, OP = 1024;
constexpr int KROWB = 416, VROWB = 288;
constexpr int SHM_K = 64 * KROWB, SHM_V = 64 * VROWB;
constexpr int LDS_V = 0, LDS_K = 2 * SHM_V, LDS_TOTAL = LDS_K + 2 * SHM_K;
constexpr float THR2 = 11.5f;
typedef __attribute__((address_space(3))) const char* lds_cptr;
typedef short v4i16_t __attribute__((ext_vector_type(4)));
#define SBAR() __builtin_amdgcn_sched_barrier(0)
__device__ __forceinline__ s16x4 vtr(lds_cptr p) { return __builtin_bit_cast(s16x4, __builtin_amdgcn_ds_read_tr16_b64_v4i16((__attribute__((address_space(3))) v4i16_t*)p)); }
__device__ __forceinline__ bf16x8 kfr(lds_cptr p) { return *(const __attribute__((address_space(3))) bf16x8*)p; }
__device__ __forceinline__ float xmax16(float x) {
    auto r = __builtin_amdgcn_permlane16_swap(__float_as_uint(x), __float_as_uint(x), false, false); x = fmaxf(__uint_as_float(r[0]), __uint_as_float(r[1]));
    auto r2 = __builtin_amdgcn_permlane32_swap(__float_as_uint(x), __float_as_uint(x), false, false); return fmaxf(__uint_as_float(r2[0]), __uint_as_float(r2[1]));
}
__device__ __forceinline__ float xsum16(float x) {
    auto r = __builtin_amdgcn_permlane16_swap(__float_as_uint(x), __float_as_uint(x), false, false); x = __uint_as_float(r[0]) + __uint_as_float(r[1]);
    auto r2 = __builtin_amdgcn_permlane32_swap(__float_as_uint(x), __float_as_uint(x), false, false); return __uint_as_float(r2[0]) + __uint_as_float(r2[1]);
}
#define MM16(acc_, a_, b_) acc_ = __builtin_amdgcn_mfma_f32_16x16x32_bf16(a_, b_, acc_, 0, 0, 0)
__device__ __forceinline__ void attn_unit(const bf16_t* Qh, const bf16_t* Kh, const bf16_t* Vh, bf16_t* Oh, int q0, char* lds, int tid) {
    asm volatile("" : "+v"(tid));
    const int wid = __builtin_amdgcn_readfirstlane(tid >> 6), lane = tid & 63, c = lane & 15, g = lane >> 4;
    const int NT = (q0 + 256) / 64;
    const int qlo = q0 + wid * 32;
    char* V_lds = lds + LDS_V; char* K_lds = lds + LDS_K;
    const int sr = tid >> 4, sc = (tid & 15) * 8, vst0 = sr * VROWB + sc * 2;
    int krc[3];
#pragma unroll
    for (int i = 0; i < 3; ++i) { const int q = tid + 512 * i, row = q / 24, cc = q - row * 24; krc[i] = (row << 5) | cc; }
    const lds_cptr l3 = (lds_cptr)lds;
    const lds_cptr kp0 = l3 + LDS_K + c * KROWB + g * 16;
    const lds_cptr vp0 = l3 + LDS_V + (4 * g + (c >> 2)) * VROWB + 8 * (c & 3);
    bf16x8 qf[2][6];
#pragma unroll
    for (int qb = 0; qb < 2; ++qb)
#pragma unroll
        for (int ks = 0; ks < 6; ++ks) qf[qb][ks] = *reinterpret_cast<const bf16x8*>(Qh + (size_t)(qlo + 16 * qb + c) * QP + 32 * ks + 8 * g);
    bf16x8 sa0, sa1, sa2, sb0, sb1, sb2, sv0, sv1;
#define KOFF(i, rowmul, ccmul) ({ int k_ = krc[i]; asm volatile("" : "+v"(k_)); (k_ >> 5) * (rowmul) + (k_ & 31) * (ccmul); })
#define KLOAD(tt, k0_, k1_, k2_) do { const bf16_t* kp_ = Kh + (size_t)(tt) * 64 * QP; \
        k0_ = *reinterpret_cast<const bf16x8*>(kp_ + KOFF(0, QP, 8)); k1_ = *reinterpret_cast<const bf16x8*>(kp_ + KOFF(1, QP, 8)); k2_ = *reinterpret_cast<const bf16x8*>(kp_ + KOFF(2, QP, 8)); } while (0)
#define VLOAD(tt) do { const bf16_t* vp_ = Vh + (size_t)(tt) * 64 * VP + (size_t)sr * VP + sc; sv0 = *reinterpret_cast<const bf16x8*>(vp_); sv1 = *reinterpret_cast<const bf16x8*>(vp_ + 32 * VP); } while (0)
#define KWRITE(ko, k0_, k1_, k2_) do { *(bf16x8*)(K_lds + (ko) + KOFF(0, KROWB, 16)) = k0_; *(bf16x8*)(K_lds + (ko) + KOFF(1, KROWB, 16)) = k1_; *(bf16x8*)(K_lds + (ko) + KOFF(2, KROWB, 16)) = k2_; } while (0)
#define VWRITE(vo) do { *(bf16x8*)(V_lds + (vo) + vst0) = sv0; *(bf16x8*)(V_lds + (vo) + vst0 + 32 * VROWB) = sv1; } while (0)
    float m_reg[2] = {0.f, 0.f}, l_reg[2] = {0.f, 0.f};
    f32x4 o[8][2];
#pragma unroll
    for (int db = 0; db < 8; ++db) { o[db][0] = (f32x4){0.f, 0.f, 0.f, 0.f}; o[db][1] = (f32x4){0.f, 0.f, 0.f, 0.f}; }
    KLOAD(0, sa0, sa1, sa2); VLOAD(0); KWRITE(0, sa0, sa1, sa2); VWRITE(0); KLOAD(1, sa0, sa1, sa2); VLOAD(1); KLOAD(2, sb0, sb1, sb2); __syncthreads();
    int kcur = 0, vcur = 0;
#define ASTEP(t, k0_, k1_, k2_) do { \
        SBAR(); \
        step_s(t); \
        SBAR(); \
        step_pv(t); \
        SBAR(); \
        KWRITE(kcur ^ SHM_K, k0_, k1_, k2_); VWRITE(vcur ^ SHM_V);     \
        KLOAD(min((t) + 3, NT - 1), k0_, k1_, k2_);                       \
        VLOAD(min((t) + 2, NT - 1)); \
        __syncthreads(); \
        kcur ^= SHM_K; vcur ^= SHM_V; } while (0)
    bf16x8 pf[2][2]; bool act;
    auto step_s = [&](int t) __attribute__((always_inline)) {
        act = 64 * t <= qlo + 31;
        if (act) {
        f32x4 s[4][2];
#pragma unroll
        for (int kb = 0; kb < 4; ++kb) { s[kb][0] = (f32x4){-m_reg[0], -m_reg[0], -m_reg[0], -m_reg[0]}; s[kb][1] = (f32x4){-m_reg[1], -m_reg[1], -m_reg[1], -m_reg[1]}; }
        { const lds_cptr kp = kp0 + kcur; bf16x8 kf[4];
#pragma unroll
          for (int kb = 0; kb < 4; ++kb) kf[kb] = kfr(kp + kb * 16 * KROWB);
          SBAR();
#pragma unroll
          for (int ks = 0; ks < 6; ++ks)
#pragma unroll
              for (int kb = 0; kb < 4; ++kb) { MM16(s[kb][0], kf[kb], qf[0][ks]); MM16(s[kb][1], kf[kb], qf[1][ks]);
                  if (ks < 5) kf[kb] = kfr(kp + kb * 16 * KROWB + (ks + 1) * 64);
                  SBAR(); } }
        if (64 * t + 63 > qlo) {
            const float NEG = -__builtin_inff();
#pragma unroll
            for (int kb = 0; kb < 4; ++kb)
#pragma unroll
                for (int qb = 0; qb < 2; ++qb)
#pragma unroll
                    for (int r = 0; r < 4; ++r) if (64 * t + 16 * kb + 4 * g + r > qlo + 16 * qb + c) s[kb][qb][r] = NEG;
        }
        float pm[2];
#pragma unroll
        for (int qb = 0; qb < 2; ++qb) { float a = fmaxf(fmaxf(s[0][qb][0], s[0][qb][1]), s[0][qb][2]), b = fmaxf(fmaxf(s[0][qb][3], s[1][qb][0]), s[1][qb][1]);
            a = fmaxf(fmaxf(a, s[1][qb][2]), s[1][qb][3]); b = fmaxf(fmaxf(b, s[2][qb][0]), s[2][qb][1]); a = fmaxf(fmaxf(a, s[2][qb][2]), s[2][qb][3]);
            b = fmaxf(fmaxf(b, s[3][qb][0]), s[3][qb][1]); a = fmaxf(fmaxf(a, s[3][qb][2]), s[3][qb][3]); pm[qb] = xmax16(fmaxf(a, b)); }
        if (__builtin_expect(t == 0 || !__all(fmaxf(pm[0], pm[1]) <= THR2), 0)) {
#pragma unroll
            for (int qb = 0; qb < 2; ++qb) { const float d = (t == 0) ? pm[qb] : fmaxf(pm[qb], 0.f); const float al = __builtin_amdgcn_exp2f(-d); m_reg[qb] += d; l_reg[qb] *= al;
#pragma unroll
                for (int kb = 0; kb < 4; ++kb) s[kb][qb] -= d;
#pragma unroll
                for (int db = 0; db < 8; ++db) o[db][qb] *= al; }
        }
#pragma unroll
        for (int qb = 0; qb < 2; ++qb) {
#pragma unroll
            for (int kb = 0; kb < 4; ++kb)
#pragma unroll
                for (int r = 0; r < 4; ++r) s[kb][qb][r] = __builtin_amdgcn_exp2f(s[kb][qb][r]);
            f32x2 s2 = {s[0][qb][0], s[0][qb][1]}; s2 += (f32x2){s[0][qb][2], s[0][qb][3]};
#pragma unroll
            for (int kb = 1; kb < 4; ++kb) { s2 += (f32x2){s[kb][qb][0], s[kb][qb][1]}; s2 += (f32x2){s[kb][qb][2], s[kb][qb][3]}; }
            l_reg[qb] += s2[0] + s2[1];
#pragma unroll
            for (int sp = 0; sp < 2; ++sp) { u32x4 w; w.x = cvt_pk_bf16(s[2 * sp][qb][0], s[2 * sp][qb][1]); w.y = cvt_pk_bf16(s[2 * sp][qb][2], s[2 * sp][qb][3]);
                w.z = cvt_pk_bf16(s[2 * sp + 1][qb][0], s[2 * sp + 1][qb][1]); w.w = cvt_pk_bf16(s[2 * sp + 1][qb][2], s[2 * sp + 1][qb][3]); pf[sp][qb] = *reinterpret_cast<bf16x8*>(&w); }
        }
        }
    };
    auto step_pv = [&](int t) __attribute__((always_inline)) {
        if (act)
        { const lds_cptr vp = vp0 + vcur; s16x4 vl[3], vh[3];
#pragma unroll
          for (int db = 0; db < 3; ++db) { vl[db] = vtr(vp + 32 * db); vh[db] = vtr(vp + 16 * VROWB + 32 * db); }
          SBAR();
#pragma unroll
          for (int i = 0; i < 16; ++i) { const int sp = i >> 3, db = i & 7, sl = i % 3;
              const bf16x8 vf = (bf16x8){vl[sl][0], vl[sl][1], vl[sl][2], vl[sl][3], vh[sl][0], vh[sl][1], vh[sl][2], vh[sl][3]};
              MM16(o[db][0], vf, pf[sp][0]); MM16(o[db][1], vf, pf[sp][1]);
              if (i + 3 < 16) { const int sp2 = (i + 3) >> 3, db2 = (i + 3) & 7; vl[sl] = vtr(vp + (32 * sp2) * VROWB + 32 * db2); vh[sl] = vtr(vp + (32 * sp2 + 16) * VROWB + 32 * db2); }
              SBAR(); } }
    };
    for (int t = 0; t < NT; t += 2) {
        ASTEP(t, sa0, sa1, sa2);
        ASTEP(t + 1, sb0, sb1, sb2);
    }
#undef ASTEP
#undef KLOAD
#undef VLOAD
#undef KWRITE
#undef VWRITE
#undef KOFF
#pragma unroll
    for (int qb = 0; qb < 2; ++qb) { const float rl = __builtin_amdgcn_rcpf(xsum16(l_reg[qb])); bf16_t* Ow = Oh + (size_t)(qlo + 16 * qb + c) * OP + 4 * g;
#pragma unroll
        for (int db = 0; db < 8; ++db) { const f32x4 v = o[db][qb] * rl; u32x2 w; w.x = cvt_pk_bf16(v[0], v[1]); w.y = cvt_pk_bf16(v[2], v[3]); *(u32x2*)(Ow + 16 * db) = w; } }
    __syncthreads();
}
#undef SBAR
#undef MM16
}

__device__ __forceinline__ int win_src(int n) {
    if (n < 1024) return 1728 + n;
    if (n < 2048) return 2752 + (n - 1024);
    if (n < 4096) return 3776 + (n - 2048);
    if (n < 6144) return 5824 + (n - 4096);
    if (n < 7168) return 704 + (n - 6144);
    if (n < 8192) return 7872 + (n - 7168);
    if (n < 9216) return 8896 + (n - 8192);
    const int m = n - 9216;
    if (m < 640) return m;
    if (m < 704) { const int p = m - 640; return 640 + ((p & 1) ? 32 + (p >> 1) : (p >> 1)); }
    return -1;
}
__device__ __forceinline__ int wq_src(int n) {
    if (n < 1024) { const int t = n >> 8, bj = (n >> 7) & 1, i = n & 127; return (2 * t + bj) * 192 + i; }
    const int m = n - 1024, t4 = m >> 8, bj = (m >> 7) & 1, hh = (m >> 5) & 3, i = m & 31; return (t4 * 4 + hh) * 192 + 128 + bj * 32 + i;
}
template <int WHICH, bool SC>
__device__ __forceinline__ void transpose_item(const float* W, int K, int Nsrc, int nkb, const float* kscale, bf16_t* WT, LAS float* scr, int item, int lane) {
    const int nb = item / nkb, kb = item - nb * nkb, k0 = 64 * kb, n0 = 64 * nb;
    float tv[2][32];
#pragma unroll
    for (int s = 0; s < 2; ++s) { const int n = n0 + 32 * s + (lane & 31); const int src = WHICH == 0 ? win_src(n) : WHICH == 1 ? wq_src(n) : n;
#pragma unroll
        for (int i = 0; i < 32; ++i) { const int kk = 2 * i + (lane >> 5); float v = 0.f; if (src >= 0) v = W[(size_t)(k0 + kk) * Nsrc + src]; tv[s][i] = v; } }
    f32x4 ks0 = {1.f, 1.f, 1.f, 1.f}, ks1 = ks0; if (SC) { ks0 = *(const f32x4*)(kscale + k0 + 8 * (lane & 7)); ks1 = *(const f32x4*)(kscale + k0 + 8 * (lane & 7) + 4); }
#pragma unroll
    for (int s = 0; s < 2; ++s) {
#pragma unroll
        for (int i = 0; i < 32; ++i) { const int kk = 2 * i + (lane >> 5); scr[kk * 33 + (lane & 31)] = tv[s][i]; }
        LDS_WAIT(); asm volatile("" ::: "memory");
        const int c = lane & 7;
#pragma unroll
        for (int j = 0; j < 4; ++j) { const int nn = (lane >> 3) + 8 * j; const LAS float* sp = scr + (8 * c) * 33 + nn;
            u32x4 o; if (SC) { o.x = pk2(sp[0 * 33] * ks0[0], sp[1 * 33] * ks0[1]); o.y = pk2(sp[2 * 33] * ks0[2], sp[3 * 33] * ks0[3]); o.z = pk2(sp[4 * 33] * ks1[0], sp[5 * 33] * ks1[1]); o.w = pk2(sp[6 * 33] * ks1[2], sp[7 * 33] * ks1[3]); }
            else { o.x = pk2(sp[0 * 33], sp[1 * 33]); o.y = pk2(sp[2 * 33], sp[3 * 33]); o.z = pk2(sp[4 * 33], sp[5 * 33]); o.w = pk2(sp[6 * 33], sp[7 * 33]); }
            *(u32x4*)(WT + (size_t)(n0 + 32 * s + nn) * K + k0 + 8 * c) = o; }
        LDS_WAIT(); asm volatile("" ::: "memory"); }
}
__device__ __forceinline__ void phase_prep(const Ctx& X, LAS unsigned char* lds) {
    for (int it = blockIdx.x; it < 8 * 12; it += X.G) {
        const int ks8 = it / 12, jb = it - ks8 * 12, col = jb * 256 + (X.tid & 255), slice = ks8 * 2 + (X.tid >> 8);
        float a = 0.f; const float* const cp = INF(I_C); const float* const wa = INF(I_WADA);
#pragma unroll 1
        for (int k0 = slice * 64; k0 < slice * 64 + 64; k0 += 32) { float w[32];
#pragma unroll
            for (int k = 0; k < 32; ++k) w[k] = wa[(size_t)(k0 + k) * 3072 + col];
#pragma unroll
            for (int k = 0; k < 32; ++k) a += siluf_(cp[k0 + k]) * w[k]; }
        ((float*)(X.ws + WS_MODP))[slice * 3072 + col] = a;
    }
    if (blockIdx.x < 8 * 12) {
        VM_WAIT(); __syncthreads();
        if (X.tid == 0) { __builtin_amdgcn_fence(__ATOMIC_RELEASE, "agent"); asm volatile("s_waitcnt vmcnt(0)" ::: "memory");
            __hip_atomic_fetch_add((unsigned*)(X.ws + WS_CTL) + CW_GEMV, 1u, __ATOMIC_RELAXED, __HIP_MEMORY_SCOPE_AGENT); }
    }
    LAS float* scr = (LAS float*)(lds + X.wave * 16384);
    const int gw = X.vcu * NWAVES + X.wave, NGW = X.G * NWAVES;
    constexpr int I_IN = (NWIN / 64) * 16, I_Q = (1536 / 64) * 6, I_KV = (2048 / 64) * 4, I_PM = 16 * 16, I_PR = 16 * 32, I_O = 16 * 16;
    constexpr int NITEMS = I_IN + I_Q + I_KV + I_PM + I_PR + I_O;
    for (int it = gw; it < NITEMS; it += NGW) {
        int r = it;
        if (r < I_IN) { transpose_item<0, false>(INF(I_WIN), 1024, 9920, 16, nullptr, (bf16_t*)(X.ws + WS_WIN), scr, r, X.lane); continue; } r -= I_IN;
        if (r < I_Q) { transpose_item<1, true>(INF(I_WQUP), 384, 1536, 6, INF(I_GQ), (bf16_t*)(X.ws + WS_WQ), scr, r, X.lane); continue; } r -= I_Q;
        if (r < I_KV) { transpose_item<2, true>(INF(I_WKVUP), 256, 2048, 4, INF(I_GKV), (bf16_t*)(X.ws + WS_WKV), scr, r, X.lane); continue; } r -= I_KV;
        if (r < I_PM) { transpose_item<2, false>(INF(I_WPM), 1024, 1024, 16, nullptr, (bf16_t*)(X.ws + WS_WPM), scr, r, X.lane); continue; } r -= I_PM;
        if (r < I_PR) { transpose_item<2, false>(INF(I_WPR), 2048, 1024, 32, nullptr, (bf16_t*)(X.ws + WS_WPR), scr, r, X.lane); continue; } r -= I_PR;
        transpose_item<2, false>(INF(I_WOUT), 1024, 1024, 16, nullptr, (bf16_t*)(X.ws + WS_WO), scr, r, X.lane);
    }
}
__device__ __forceinline__ void phase_h(const Ctx& X, LAS unsigned char* lds) {
    LAS float* modl = (LAS float*)lds;
    if (X.tid == 0) { unsigned sp = 0; const unsigned* cg = (const unsigned*)(X.ws + WS_CTL) + CW_GEMV;
        while (__hip_atomic_load(cg, __ATOMIC_RELAXED, __HIP_MEMORY_SCOPE_AGENT) < 96u) { __builtin_amdgcn_s_sleep(8); if (++sp > (1u << 22)) break; }
        __builtin_amdgcn_fence(__ATOMIC_ACQUIRE, "agent"); asm volatile("s_waitcnt vmcnt(0)" ::: "memory"); }
    __syncthreads();
    const float* const badap = INF(I_BADA); const float* const gprep = INF(I_GPRE); const float* const xp = INF(I_X);
    { float pv[4][16], bv[4];
#pragma unroll
      for (int q = 0; q < 4; ++q) { const float* mp = (const float*)(X.ws + WS_MODP) + X.tid + 512 * q; bv[q] = badap[X.tid + 512 * q];
#pragma unroll
          for (int s = 0; s < 16; ++s) pv[q][s] = mp[s * 3072]; }
#pragma unroll
      for (int q = 0; q < 4; ++q) { const int j = X.tid + 512 * q; float a = bv[q];
#pragma unroll
          for (int s = 0; s < 16; ++s) a += pv[q][s];
          modl[j] = a; if (blockIdx.x == 0) ((float*)(X.ws + WS_MOD))[j] = a; } }
    if (blockIdx.x == 0) {
        float pv[2][16], bv[2];
#pragma unroll
        for (int q = 0; q < 2; ++q) { const float* mp = (const float*)(X.ws + WS_MODP) + 2048 + X.tid + 512 * q; bv[q] = badap[2048 + X.tid + 512 * q];
#pragma unroll
            for (int s = 0; s < 16; ++s) pv[q][s] = mp[s * 3072]; }
#pragma unroll
        for (int q = 0; q < 2; ++q) { float a = bv[q];
#pragma unroll
            for (int s = 0; s < 16; ++s) a += pv[q][s];
            ((float*)(X.ws + WS_MOD))[2048 + X.tid + 512 * q] = a; } }
    __syncthreads();
    f32x4 ca[4], cb[4];
#pragma unroll
    for (int j = 0; j < 4; ++j) { const int col = 256 * j + 4 * X.lane;
#pragma unroll
        for (int q = 0; q < 4; ++q) { ca[j][q] = gprep[col + q] * (1.0f + modl[1024 + col + q]); cb[j][q] = modl[col + q]; } }
    const int gw = X.vcu * NWAVES + X.wave, NGW = X.G * NWAVES;
    {
        f32x4 v[8][4];
#pragma unroll
        for (int r = 0; r < 8; ++r) { const f32x4* xr = (const f32x4*)(xp + (size_t)(gw + r * NGW) * DM) + X.lane;
#pragma unroll
            for (int j = 0; j < 4; ++j) v[r][j] = xr[64 * j]; }
#pragma unroll
        for (int r = 0; r < 8; ++r) { float s2 = 0.f;
#pragma unroll
            for (int j = 0; j < 4; ++j) s2 += (v[r][j][0] * v[r][j][0] + v[r][j][1] * v[r][j][1]) + (v[r][j][2] * v[r][j][2] + v[r][j][3] * v[r][j][3]);
            const float rstd = __builtin_amdgcn_rsqf(wave_sum(s2) * (1.0f / DM) + EPS);
            u32x2* o8 = (u32x2*)((bf16_t*)(X.ws + WS_H) + (size_t)(gw + r * NGW) * DM) + X.lane;
#pragma unroll
            for (int j = 0; j < 4; ++j) { const f32x4 y = v[r][j] * rstd * ca[j] + cb[j]; u32x2 w; w.x = pk2(y[0], y[1]); w.y = pk2(y[2], y[3]); o8[64 * j] = w; } }
    }
    __syncthreads();
}
__device__ __forceinline__ void phase_scan(const Ctx& X) {
    const int gt = blockIdx.x * NTHR + X.tid;
    const int h = gt >> 15, e = (gt >> 7) & 255, d2 = gt & 127; const float g = fast_exp2(256.0f * l2gamma(h));
    unsigned* p = (unsigned*)((bf16_t*)(X.ws + WS_VRH) + ((size_t)(h * 256 + e) * 64) * 512 + 256 + 2 * d2);
    float r0 = 0.f, r1 = 0.f;
#pragma unroll 1
    for (int c0 = 0; c0 < 64; c0 += 32) {
        unsigned u[32];
#pragma unroll
        for (int c = 0; c < 32; ++c) u[c] = p[(size_t)(c0 + c) * 256];
#pragma unroll
        for (int c = 0; c < 32; ++c) { p[(size_t)(c0 + c) * 256] = cvt_pk_bf16(r0, r1); r0 = g * r0 + bflo(u[c]); r1 = g * r1 + bfhi(u[c]); }
    }
}
__device__ __forceinline__ void phase_norm(const Ctx& X) {
    const int gw = X.vcu * NWAVES + X.wave, NGW = X.G * NWAVES; const float* fsq = (const float*)(X.ws + WS_FSQ);
    f32x4 gf[4];
#pragma unroll
    for (int j = 0; j < 4; ++j) gf[j] = *((const f32x4*)INF(I_GFINAL) + 64 * j + X.lane);
    for (int m0 = gw; m0 < SEQ; m0 += 4 * NGW) {
        f32x4 v[4][4], q[4][4];
#pragma unroll
        for (int r = 0; r < 4; ++r) { const int m = m0 + r * NGW; const f32x4* sp = (const f32x4*)(fsq + (size_t)m * 16); const f32x4* xr = (const f32x4*)(X.out + (size_t)m * DM) + X.lane;
#pragma unroll
            for (int j = 0; j < 4; ++j) { q[r][j] = sp[j]; v[r][j] = xr[64 * j]; } }
#pragma unroll
        for (int r = 0; r < 4; ++r) { const int m = m0 + r * NGW; float ss = 0.f;
#pragma unroll
            for (int j = 0; j < 4; ++j) ss += (q[r][j][0] + q[r][j][1]) + (q[r][j][2] + q[r][j][3]);
            const float rstd = 1.0f / sqrtf(ss * (1.0f / DM) + EPS);
            f32x4* xr = (f32x4*)(X.out + (size_t)m * DM) + X.lane;
#pragma unroll
            for (int j = 0; j < 4; ++j) xr[64 * j] = v[r][j] * rstd * gf[j]; }
    }
}

enum Op { OP_PREP = 0, OP_H, OP_GEMM, OP_SCAN, OP_ATTN, OP_NORM };
enum Sync { SY_NONE = 0, SY_LOCAL, SY_GRID, SY_PANEL, SY_AFLAG, SY_WAR };
struct Step { int op, sync; GCall g; };
__device__ const Step STEPS[] = {
    {OP_PREP, SY_NONE, {0, 0, 0, 0, 0, 0, 0}},
    {OP_H,    SY_GRID, {0, 0, 0, 0, 0, 0, 0}},
    {OP_GEMM, SY_NONE,  {K_QK,    8, 1024, 1024, 1024, 0, 0}},
    {OP_GEMM, SY_NONE,  {K_TRANS, 4, 1024, 1024, 1024, 0, 0}},
    {OP_GEMM, SY_LOCAL, {K_LOW,   3, 1024, 1024, 1024, 0, 0}},
    {OP_GEMM, SY_NONE,  {K_S,     4, 256,  512,  256,  0, 0}},
    {OP_GEMM, SY_GRID,  {K_U,     4, 256, 32768, SEQ,  0, 0}},
    {OP_SCAN, SY_GRID,  {0, 0, 0, 0, 0, 0, 0}},
    {OP_GEMM, SY_NONE,  {K_MAIN,  4, 512,  512, 32768, 0, 0}},
    {OP_GEMM, SY_LOCAL, {K_TRANS, 4, 1024, 1024, 1024, 1, 0}},
    {OP_GEMM, SY_GRID,  {K_U,     4, 256, 32768, SEQ,  1, 0}},
    {OP_SCAN, SY_GRID,  {0, 0, 0, 0, 0, 0, 0}},
    {OP_GEMM, SY_NONE,  {K_MAIN,  4, 512,  512, 32768, 1, 0}},
    {OP_GEMM, SY_WAR,   {K_GRET,  8, 1024, 1024, 1024, 0, 0}},
    {OP_GEMM, SY_NONE,  {K_QUP,   6, 384,  384,  384,  0, 0}},
    {OP_GEMM, SY_GRID,  {K_KVUP,  8, 256,  256,  256,  0, 0}},
    {OP_ATTN, SY_AFLAG, {0, 0, 0, 0, 0, 0, 0}},
    {OP_GEMM, SY_NONE,  {K_GMLA,  4, 1024, 1024, 1024, 0, 0}},
    {OP_GEMM, SY_PANEL, {K_P0,    4, 1024, 1024, 1024, 0, 1}},
    {OP_GEMM, SY_NONE,  {K_P1,    4, 1024, 1024, 1024, 0, 0}},
    {OP_GEMM, SY_NONE,  {K_P2,    4, 1024, 1024, 1024, 0, 0}},
    {OP_GEMM, SY_PANEL, {K_P3,    4, 2048, 2048, 2048, 0, 2}},
    {OP_GEMM, SY_NONE,  {K_FINAL, 4, 1024, 1024, 1024, 0, 0}} };
constexpr int NSTEPS = 23;
__device__ __forceinline__ GCall step_call(int si) { return STEPS[si].g; }

constexpr int NPHASES = NSTEPS;
struct Args { const void* in[16]; float* out; unsigned char* ws; int ph_lo, ph_hi; };
__global__ void __launch_bounds__(NTHR, 2) fwd_kernel(Args args) {
    extern __shared__ __attribute__((aligned(16))) unsigned char lds_raw[];
    LAS unsigned char* lds = (LAS unsigned char*)lds_raw;
    Ctx X; X.out = args.out; X.ws = args.ws;
    X.tid = threadIdx.x; X.lane = X.tid & 63; X.wave = __builtin_amdgcn_readfirstlane(X.tid >> 6);
    X.G = gridDim.x; { const int bx = blockIdx.x; X.vcu = (bx % 8) * (X.G / 8) + bx / 8; }
    volatile LAS unsigned* MISC = (volatile LAS unsigned*)(lds + MISC_OFF);
    for (int u = X.tid; u < (LDS_BYTES - LDSCTL_OFF) / 4; u += NTHR) ((LAS unsigned*)(lds + LDSCTL_OFF))[u] = 0u;
    __syncthreads();
    if (X.tid < 16) *(LAS unsigned long long*)(lds + PTR_OFF + 8 * X.tid) = (unsigned long long)args.in[X.tid];
    if (X.tid == 16) *(LAS unsigned long long*)(lds + PTR_OFF + 8 * 16) = (unsigned long long)args.out;
    if (X.tid == 17) *(LAS unsigned long long*)(lds + PTR_OFF + 8 * 17) = (unsigned long long)args.ws;
    __syncthreads();
    gu32* ctl = (gu32*)(X.ws + WS_CTL);
    XcdBarrier bar = xcd_barrier_post((unsigned*)(ctl + CW_BAR), MISC + 8);
    const int lo = args.ph_lo, hi = args.ph_hi;
    const Ctx X_ = X;
    for (int si = lo; si < hi; ++si) {
        Ctx X = X_; asm volatile("" : "+v"(X.tid), "+v"(X.lane), "+s"(X.wave), "+s"(X.vcu)); X.out = (float*)inptr_raw(16); X.ws = (unsigned char*)inptr_raw(17);
        const int op = STEPS[si].op, sync = STEPS[si].sync;
        if (op == OP_PREP) phase_prep(X, lds);
        else if (op == OP_H) phase_h(X, lds);
        else if (op == OP_SCAN) phase_scan(X);
        else if (op == OP_ATTN) {
            const int head = X.vcu >> 5, l = X.vcu & 31;
            const bf16_t* Qh = (const bf16_t*)(X.ws + WS_Q) + head * 192; const bf16_t* Kh = (const bf16_t*)(X.ws + WS_K) + head * 192; const bf16_t* Vh = (const bf16_t*)(X.ws + WS_V) + head * 128;
            bf16_t* Oh = (bf16_t*)(X.ws + WS_O) + head * 128;
#pragma unroll 1
            for (int pass = 0; pass < 2; ++pass) att16::attn_unit(Qh, Kh, Vh, Oh, 256 * (pass ? 63 - l : l), (char*)lds_raw, X.tid);
        }
        else if (op == OP_NORM) phase_norm(X);
        int sync_ = sync;
        if (op == OP_GEMM) { int ns = 1; while (si + ns < hi && STEPS[si + ns - 1].sync == SY_NONE && STEPS[si + ns].op == OP_GEMM) ++ns;
            gemm_stream(lds, si, ns, X); si += ns - 1; sync_ = STEPS[si].sync; }
        if (si + 1 < hi) {
            if (sync_ == SY_GRID) { xcd_barrier(bar);
            }
            else if (sync_ == SY_PANEL) {
                VM_WAIT(); __syncthreads();
                if (X.tid == 0) { unsigned* cp = (unsigned*)(X.ws + WS_CTL) + CW_PANEL + 64 * (8 * (X.vcu >> 5) + (X.vcu & 7));
                    __builtin_amdgcn_fence(__ATOMIC_RELEASE, "agent"); asm volatile("s_waitcnt vmcnt(0)" ::: "memory");
                    __hip_atomic_fetch_add(cp, 1u, __ATOMIC_RELAXED, __HIP_MEMORY_SCOPE_AGENT);
                    const unsigned panel_need = 4u * (unsigned)STEPS[si].g.nk;
                    unsigned sp = 0; while (__hip_atomic_load(cp, __ATOMIC_RELAXED, __HIP_MEMORY_SCOPE_AGENT) < panel_need) { __builtin_amdgcn_s_sleep(4); if (++sp > (1u << 22)) break; }
                    __builtin_amdgcn_fence(__ATOMIC_ACQUIRE, "agent"); asm volatile("s_waitcnt vmcnt(0)" ::: "memory"); }
                __syncthreads(); }
            else if (sync_ == SY_AFLAG) {
                VM_WAIT(); __syncthreads();
                if (X.tid == 0) { unsigned* fl = (unsigned*)(X.ws + WS_CTL) + CW_AFLAG; const int l_ = X.vcu & 31;
                    __builtin_amdgcn_fence(__ATOMIC_RELEASE, "agent"); asm volatile("s_waitcnt vmcnt(0)" ::: "memory");
                    __hip_atomic_fetch_add((unsigned*)(X.ws + WS_CTL) + CW_ADONE, 1u, __ATOMIC_RELAXED, __HIP_MEMORY_SCOPE_AGENT);
                    __hip_atomic_store(fl + (X.vcu >> 5) * 64 + l_, 1u, __ATOMIC_RELAXED, __HIP_MEMORY_SCOPE_AGENT); __hip_atomic_store(fl + (X.vcu >> 5) * 64 + 63 - l_, 1u, __ATOMIC_RELAXED, __HIP_MEMORY_SCOPE_AGENT);
                    const int t_ = 8 * (X.vcu >> 5) + (X.vcu & 7), o_ = (X.vcu & 31) >> 3; const unsigned* f0 = fl + (2 * o_) * 64 + t_;
                    unsigned sp = 0; while ((__hip_atomic_load(f0, __ATOMIC_RELAXED, __HIP_MEMORY_SCOPE_AGENT) & __hip_atomic_load(f0 + 64, __ATOMIC_RELAXED, __HIP_MEMORY_SCOPE_AGENT)) == 0u) { __builtin_amdgcn_s_sleep(4); if (++sp > (1u << 22)) break; }
                    __builtin_amdgcn_fence(__ATOMIC_ACQUIRE, "agent"); asm volatile("s_waitcnt vmcnt(0)" ::: "memory"); }
                __syncthreads(); }
            else if (sync_ == SY_WAR) {
                VM_WAIT(); __syncthreads();
                if (X.tid == 0) { const unsigned* cw = (const unsigned*)(X.ws + WS_CTL) + CW_WAR;
                    unsigned sp = 0; while (__hip_atomic_load(cw, __ATOMIC_RELAXED, __HIP_MEMORY_SCOPE_AGENT) < (unsigned)X.G) { __builtin_amdgcn_s_sleep(4); if (++sp > (1u << 22)) break; }
                    __builtin_amdgcn_fence(__ATOMIC_ACQUIRE, "agent"); asm volatile("s_waitcnt vmcnt(0)" ::: "memory"); }
                __syncthreads(); }
            else if (sync_ == SY_LOCAL) { VM_WAIT(); __syncthreads(); if (X.tid == 0) { __builtin_amdgcn_fence(__ATOMIC_ACQUIRE, "agent"); } VM_WAIT(); __syncthreads(); }
        }
    }
}


extern "C" void kernel_launch(void* const* d_in, const int* in_sizes, int n_in, void* d_out, int out_size, void* d_ws, size_t ws_size, hipStream_t stream) {
    static int grid = 0;
    if (grid == 0) {
        if (n_in != 16 || out_size != SEQ * DM || ws_size < WS_END) { fprintf(stderr, "kernel_launch: unexpected shapes (n_in %d out %d ws %zu)\n", n_in, out_size, ws_size); grid = -1; return; }
        int dev = 0, cus = 0;
        if (hipGetDevice(&dev) != hipSuccess || hipDeviceGetAttribute(&cus, hipDeviceAttributeMultiprocessorCount, dev) != hipSuccess) { grid = -1; return; }
        if (hipFuncSetAttribute((const void*)fwd_kernel, hipFuncAttributeMaxDynamicSharedMemorySize, LDS_BYTES) != hipSuccess) { fprintf(stderr, "kernel_launch: hipFuncSetAttribute failed\n"); grid = -1; return; }
        (void)hipGetLastError();
        grid = cus;
        if (grid != 256) { fprintf(stderr, "kernel_launch: built for 256 CUs, found %d\n", cus); grid = -1; return; }
    }
    if (grid < 0) return;
    (void)in_sizes;
    if (hipMemsetAsync((char*)d_ws + WS_CTL, 0, CTL_ZERO_BYTES, stream) != hipSuccess) return;
    Args a{};
    for (int i = 0; i < 16; ++i) a.in[i] = d_in[i];
    a.out = (float*)d_out; a.ws = (unsigned char*)d_ws; a.ph_lo = 0; a.ph_hi = NPHASES;
    hipLaunchKernelGGL(fwd_kernel, dim3(grid), dim3(NTHR), LDS_BYTES, stream, a);
}
```

```cpp
#include <hip/hip_runtime.h>
#include <cstdio>
#include <cstdint>

#define GAS __attribute__((address_space(1)))
#define LAS __attribute__((address_space(3)))
typedef unsigned short bf16_t;
typedef short bf16x8 __attribute__((ext_vector_type(8)));
typedef short s16x4 __attribute__((ext_vector_type(4)));
typedef float f32x4 __attribute__((ext_vector_type(4)));
typedef float f32x2 __attribute__((ext_vector_type(2)));
typedef float f32x16 __attribute__((ext_vector_type(16)));
typedef unsigned u32x4 __attribute__((ext_vector_type(4)));
typedef unsigned u32x2 __attribute__((ext_vector_type(2)));
typedef GAS unsigned gu32;

constexpr int SEQ = 16384, DM = 1024;
constexpr int NWAVES = 8, NTHR = 512;
constexpr float EPS = 1e-6f;
constexpr int NWIN = 9984;
constexpr int WT_QRET = 0, WT_KRET = 4, WT_VRET = 8, WT_GRET = 16, WT_GMLA = 24, WT_MMLA = 28, WT_MRET = 32, WT_LOW = 36;

constexpr size_t MiB = 1u << 20;
constexpr size_t WS_CTL = 0, CTL_ZERO_BYTES = 64 * 1024;
constexpr size_t WS_MODP = 128 * 1024;
constexpr size_t WS_MOD = 512 * 1024;
constexpr size_t WS_FSQ = 1 * MiB;
constexpr size_t WS_PSQ = 2 * MiB;
constexpr size_t WS_STAT = 4 * MiB;
constexpr size_t WS_WIN = 8 * MiB;
constexpr size_t WS_WQ = 28 * MiB;
constexpr size_t WS_WKV = 30 * MiB;
constexpr size_t WS_WPM = 31 * MiB;
constexpr size_t WS_WPR = 33 * MiB;
constexpr size_t WS_WO = 37 * MiB;
constexpr size_t WS_H = 40 * MiB;
constexpr size_t WS_X = 72 * MiB;
constexpr size_t WS_AQ = WS_X;
constexpr size_t WS_VRH = WS_X + 64 * MiB;
constexpr size_t WS_KZT = WS_X + 128 * MiB;
constexpr size_t WS_CQ = WS_X + 160 * MiB;
constexpr size_t WS_CKV = WS_X + 172 * MiB;
constexpr size_t WS_KROPE = WS_X + 180 * MiB;
constexpr size_t WS_Q = WS_X + 24 * MiB;
constexpr size_t WS_K = WS_X + 72 * MiB;
constexpr size_t WS_V = WS_X + 120 * MiB;
constexpr size_t WS_O = WS_X + 152 * MiB;
constexpr size_t WS_SCRA = WS_X;
constexpr size_t WS_SCRB = WS_X + 32 * MiB;
constexpr size_t WS_SCRA2 = WS_X + 64 * MiB;
constexpr size_t WS_MERGED = WS_X + 96 * MiB;
constexpr size_t WS_END = 256 * MiB;

constexpr int CW_BAR = 4096;
constexpr int CW_CNT = 8192;
constexpr int CW_PANEL = 12288;
constexpr int CW_ADONE = 2816;
constexpr int CW_WAR = 2560;
constexpr int CW_GEMV = 2048;
constexpr int CW_AFLAG = 3072;

constexpr int RING_BYTES = 131072;
constexpr int LDSCTL_OFF = RING_BYTES, MISC_OFF = LDSCTL_OFF + 320;
constexpr int LDS_BYTES = 147456;

#define RLX_AGENT __ATOMIC_RELAXED, __HIP_MEMORY_SCOPE_AGENT
#define LDS_WAIT() asm volatile("s_waitcnt lgkmcnt(0)" ::: "memory")
#define VM_WAIT() asm volatile("s_waitcnt vmcnt(0)" ::: "memory")
__device__ __forceinline__ unsigned f2bf(float f) { unsigned u = __builtin_bit_cast(unsigned, f); return (u + 0x7fffu + ((u >> 16) & 1u)) >> 16; }
__device__ __forceinline__ unsigned pk2(float lo, float hi) { return f2bf(lo) | (f2bf(hi) << 16); }
__device__ __forceinline__ float bf2f(unsigned short b) { return __builtin_bit_cast(float, ((unsigned)b) << 16); }
__device__ __forceinline__ float bflo(unsigned w) { return __builtin_bit_cast(float, w << 16); }
__device__ __forceinline__ float bfhi(unsigned w) { return __builtin_bit_cast(float, w & 0xffff0000u); }
typedef __bf16 bf16x2_t __attribute__((ext_vector_type(2)));
__device__ __forceinline__ unsigned cvt_pk_bf16(float lo, float hi) { f32x2 v = {lo, hi}; bf16x2_t b = __builtin_convertvector(v, bf16x2_t); return __builtin_bit_cast(unsigned, b); }
__device__ __forceinline__ float fast_exp2(float x) { return __builtin_amdgcn_exp2f(x); }
__device__ __forceinline__ float fast_rcp(float x) { return __builtin_amdgcn_rcpf(x); }
__device__ __forceinline__ float sigmoidf_(float x) { return fast_rcp(1.0f + fast_exp2(-1.4426950408889634f * x)); }
__device__ __forceinline__ float siluf_(float x) { return x * sigmoidf_(x); }
__device__ __forceinline__ void sincos_ang(float ang, float& s, float& c) {
    const float hi = 0.15915493667125702f, lo = 6.420638326565253e-09f;
    const float p = ang * hi; float e = __builtin_fmaf(ang, hi, -p); e = __builtin_fmaf(ang, lo, e);
    const float f = (p - __builtin_rintf(p)) + e;
    s = __builtin_amdgcn_sinf(f); c = __builtin_amdgcn_cosf(f);
}
__device__ __forceinline__ float wave_sum(float v) {
#pragma unroll
    for (int o = 1; o < 64; o <<= 1) v += __shfl_xor(v, o);
    return v;
}
__device__ const float INVF[128] = { 1.000000000e+00f, 9.305720329e-01f, 8.659643531e-01f, 8.058421612e-01f, 7.498942018e-01f, 6.978305578e-01f, 6.493816376e-01f, 6.042963862e-01f, 5.623413324e-01f, 5.232990980e-01f, 4.869675338e-01f, 4.531583786e-01f, 4.216965139e-01f, 3.924189806e-01f, 3.651741147e-01f, 3.398208320e-01f, 3.162277639e-01f, 2.942727208e-01f, 2.738419771e-01f, 2.548296750e-01f, 2.371373773e-01f, 2.206734121e-01f, 2.053525001e-01f, 1.910952926e-01f, 1.778279394e-01f, 1.654817164e-01f, 1.539926529e-01f, 1.433012635e-01f, 1.333521456e-01f, 1.240937784e-01f, 1.154781953e-01f, 1.074607819e-01f, 1.000000015e-01f, 9.305720776e-02f, 8.659642935e-02f, 8.058422059e-02f, 7.498942316e-02f, 6.978306174e-02f, 6.493816525e-02f, 6.042964011e-02f, 5.623413250e-02f, 5.232991278e-02f, 4.869675264e-02f, 4.531583562e-02f, 4.216964915e-02f, 3.924189880e-02f, 3.651741147e-02f, 3.398208320e-02f, 3.162277490e-02f, 2.942727134e-02f, 2.738419548e-02f, 2.548296750e-02f, 2.371373773e-02f, 2.206734009e-02f, 2.053525113e-02f, 1.910953037e-02f, 1.778279431e-02f, 1.654817164e-02f, 1.539926510e-02f, 1.433012541e-02f, 1.333521400e-02f, 1.240937784e-02f, 1.154781971e-02f, 1.074607857e-02f, 9.999999776e-03f, 9.305720218e-03f, 8.659643121e-03f, 8.058422245e-03f, 7.498942316e-03f, 6.978305988e-03f, 6.493816152e-03f, 6.042963825e-03f, 5.623413250e-03f, 5.232991185e-03f, 4.869675264e-03f, 4.531583749e-03f, 4.216964822e-03f, 3.924189601e-03f, 3.651741194e-03f, 3.398208413e-03f, 3.162277630e-03f, 2.942727180e-03f, 2.738419687e-03f, 2.548296703e-03f, 2.371373819e-03f, 2.206734149e-03f, 2.053525066e-03f, 1.910952968e-03f, 1.778279431e-03f, 1.654817141e-03f, 1.539926510e-03f, 1.433012541e-03f, 1.333521446e-03f, 1.240937738e-03f, 1.154782018e-03f, 1.074607833e-03f, 1.000000047e-03f, 9.305720450e-04f, 8.659643354e-04f, 8.058421663e-04f, 7.498941850e-04f, 6.978305755e-04f, 6.493816036e-04f, 6.042963942e-04f, 5.623413017e-04f, 5.232990952e-04f, 4.869675322e-04f, 4.531583691e-04f, 4.216965172e-04f, 3.924189659e-04f, 3.651741135e-04f, 3.398208355e-04f, 3.162277571e-04f, 2.942727297e-04f, 2.738419571e-04f, 2.548296761e-04f, 2.371373703e-04f, 2.206734061e-04f, 2.053525095e-04f, 1.910952997e-04f, 1.778279402e-04f, 1.654817170e-04f, 1.539926598e-04f, 1.433012512e-04f, 1.333521504e-04f, 1.240937709e-04f, 1.154782003e-04f, 1.074607862e-04f };
__device__ __forceinline__ float l2gamma(int h) { return h == 0 ? -0.04580368961312479f : h == 1 ? -0.02272007650008353f : h == 2 ? -0.011315313227834146f : -0.005646563141142063f; }

#define XB_TMO      128
#define XB_XCNT(j)  (256  + 64 * (j))
#define XB_XSUB(j)  (1280 + 64 * (j))
#define XB_XGEN(j)  (2304 + 64 * (j))
#define XB_TOP      3328
#define XB_TOPGEN   3392
#define XCD_BAR_WORDS 3456
#define XB_SPIN_CAP (1u << 18)
__device__ __forceinline__ unsigned xb_ld(unsigned* p)              { return __hip_atomic_load(p, __ATOMIC_RELAXED, __HIP_MEMORY_SCOPE_AGENT); }
__device__ __forceinline__ unsigned xb_add(unsigned* p, unsigned v) { return __hip_atomic_fetch_add(p, v, __ATOMIC_RELAXED, __HIP_MEMORY_SCOPE_AGENT); }
__device__ __forceinline__ unsigned xb_xcc_id() { return (unsigned)__builtin_amdgcn_s_getreg((3 << 11) | 20) & 0xFu; }
#define XB_SPIN(cond, bar) do { unsigned _sp = 0; while (cond) { __builtin_amdgcn_s_sleep(1); \
    if ((++_sp & 255u) == 0u) { if (xb_ld(&(bar)[XB_TMO])) break; if (_sp > XB_SPIN_CAP) { atomicAdd(&(bar)[XB_TMO], 1u); break; } } } } while (0)
struct XcdBarrier { unsigned* bar; unsigned x; volatile LAS unsigned* st; };
__device__ __forceinline__ XcdBarrier xcd_barrier_post(unsigned* bar, volatile LAS unsigned* st) {
    XcdBarrier b; b.bar = bar; b.x = xb_xcc_id(); b.st = st;
    if (threadIdx.x == 0) (void)xb_add(&bar[XB_XCNT(b.x)], 1u);
    return b;
}
__device__ __forceinline__ void xcd_barrier_complete(unsigned* bar, unsigned x, unsigned& nloc, unsigned& nx) {
    const unsigned G = gridDim.x * gridDim.y * gridDim.z;
    unsigned sum, cnt, mine, sp = 0u;
    for (;;) {
        sum = 0u; cnt = 0u; mine = 0u;
#pragma unroll
        for (unsigned j = 0; j < 16; ++j) { const unsigned c = xb_ld(&bar[XB_XCNT(j)]); sum += c; cnt += (c > 0u) ? 1u : 0u; mine = (j == x) ? c : mine; }
        if (sum == G) break;
        __builtin_amdgcn_s_sleep(1);
        if ((++sp & 255u) == 0u) { if (xb_ld(&bar[XB_TMO])) break; if (sp > XB_SPIN_CAP) { atomicAdd(&bar[XB_TMO], 1u); break; } }
    }
    nloc = mine > 0u ? mine : 1u; nx = cnt > 0u ? cnt : 1u;
}
__device__ __forceinline__ void xcd_barrier(const XcdBarrier& b) {
    asm volatile("s_waitcnt vmcnt(0)" ::: "memory");
    __syncthreads();
    if (threadIdx.x == 0) {
        unsigned* bar = b.bar;
        __builtin_amdgcn_s_waitcnt(0);
        unsigned nloc = b.st[0], nx = b.st[1];
        if (nloc == 0u) { xcd_barrier_complete(bar, b.x, nloc, nx); b.st[0] = nloc; b.st[1] = nx; }
        const unsigned old = xb_add(&bar[XB_XSUB(b.x)], 1u);
        const unsigned gen = old / nloc;
        if (old + 1u == (gen + 1u) * nloc) {
            __builtin_amdgcn_fence(__ATOMIC_RELEASE, "agent");
            asm volatile("s_waitcnt vmcnt(0)" ::: "memory");
            const unsigned og = xb_add(&bar[XB_TOP], 1u);
            const unsigned tg = og / nx;
            if (og + 1u == (tg + 1u) * nx) xb_add(&bar[XB_TOPGEN], 1u);
            else XB_SPIN(xb_ld(&bar[XB_TOPGEN]) == tg, bar);
            __builtin_amdgcn_fence(__ATOMIC_ACQUIRE, "agent");
            xb_add(&bar[XB_XGEN(b.x)], 1u);
            asm volatile("s_waitcnt vmcnt(0)" ::: "memory");
        } else {
            XB_SPIN(xb_ld(&bar[XB_XGEN(b.x)]) == gen, bar);
            __builtin_amdgcn_fence(__ATOMIC_ACQUIRE, "agent");
            asm volatile("s_waitcnt vmcnt(0)" ::: "memory");
        }
    }
    __syncthreads();
}

struct Ctx {
    float* out; unsigned char* ws;
    int tid, lane, wave, vcu, G;
};
enum InIdx { I_X = 0, I_C, I_POS, I_WADA, I_BADA, I_GPRE, I_WIN, I_GQ, I_WQUP, I_GKV, I_WKVUP, I_GRET, I_WPM, I_WPR, I_WOUT, I_GFINAL };
constexpr int PTR_OFF = LDSCTL_OFF;
__device__ __forceinline__ const void* inptr_raw(int k) {
    const volatile LAS unsigned* p = (const volatile LAS unsigned*)(size_t)(PTR_OFF + 8 * k);
    const unsigned lo = (unsigned)__builtin_amdgcn_readfirstlane((int)p[0]), hi = (unsigned)__builtin_amdgcn_readfirstlane((int)p[1]);
    return (const void*)(const GAS char*)(((unsigned long long)hi << 32) | lo);
}
#define INF(k) ((const float*)inptr_raw(k))
#define INI(k) ((const int*)inptr_raw(k))

enum Kind { K_QK = 0, K_TRANS, K_S, K_U, K_MAIN, K_LOW, K_QUP, K_KVUP, K_GMLA, K_GRET, K_P0, K_P1, K_P2, K_P3, K_FINAL };
struct GCall { int kind, NO, K, lda, ldb, hf, nk; };
struct Unit { int t, o; };
constexpr int BK = 64, HALF = 128, HTB = HALF * BK * 2;
constexpr float QSCALE = 0.07216878364870322f * 1.4426950408889634f;

__host__ __device__ __forceinline__ int lds_byte(int r, int c) { const int st = (r >> 4) * 2 + (c >> 5), rr = r & 15, cc = c & 31, ob = rr * 64 + cc * 2; return st * 1024 + (ob ^ (((ob >> 9) & 1) << 5)); }
__host__ __device__ __forceinline__ void stage_rc(int b, int& R, int& C) { const int st = b / 1024, sb = b % 1024, swz = sb ^ (((sb >> 9) & 1) << 5); R = (st >> 1) * 16 + swz / 64; C = (st & 1) * 32 + (swz % 64) / 2; }
__host__ __device__ __forceinline__ int perm32(int rho) { const int n = rho >> 4, i = rho & 15; return 8 * (i >> 2) + 4 * n + (i & 3); }

__device__ __forceinline__ bool unit_next(const GCall& g, int vcu, int i, Unit& u) {
    const int x = vcu >> 5, l = vcu & 31; u.t = 8 * x + (l & 7);
    if (g.kind == K_GRET) { u.o = 2 * (l >> 3) + i; return i < 2; }
    if (g.kind == K_KVUP) { const int q4 = l >> 3; if (q4 < 2) { u.o = q4; return i < 1; } u.o = q4 + 2 * i; return i < 3; }
    u.o = 4 * i + (l >> 3); return u.o < g.NO;
}
__device__ __forceinline__ void unit_ptrs(const GCall& g, const Ctx& X, const Unit& u, const char*& A, const char*& B) {
    size_t z_ = 0; asm volatile("" : "+s"(z_)); const unsigned char* wsb = X.ws + z_; const float* outb = X.out + z_;
    const bf16_t* a = nullptr; const bf16_t* b = nullptr;
    const bf16_t* Hb = (const bf16_t*)(wsb + WS_H); const bf16_t* Win = (const bf16_t*)(wsb + WS_WIN);
    const size_t t = (size_t)u.t, o = (size_t)u.o;
    switch (g.kind) {
    case K_QK:    a = Hb + t * 256 * 1024; b = Win + o * 256 * 1024; break;
    case K_TRANS: { const size_t rt = (u.o < g.nk) ? (size_t)(WT_KRET + u.o) : (size_t)(WT_VRET + (u.o - g.nk) * 2 + g.hf); a = Win + rt * 256 * 1024; b = Hb + t * 256 * 1024; } break;
    case K_S:     a = (const bf16_t*)(wsb + WS_AQ) + (o * SEQ + t * 256) * 512 + 256; b = (const bf16_t*)outb + (o * SEQ + t * 256) * 256; break;
    case K_U:     a = (const bf16_t*)(wsb + WS_VRH) + ((o * 256) * 64 + t) * 512; b = (const bf16_t*)(wsb + WS_KZT) + (o * 256) * (size_t)SEQ + t * 256; break;
    case K_MAIN:  a = (const bf16_t*)(wsb + WS_AQ) + (o * SEQ + t * 256) * 512; b = (const bf16_t*)(wsb + WS_VRH) + ((o * 256) * 64 + t) * 512; break;
    case K_LOW:   a = Hb + t * 256 * 1024; b = Win + (WT_LOW + o) * 256 * 1024; break;
    case K_QUP:   a = (const bf16_t*)(wsb + WS_CQ) + t * 256 * 384; b = (const bf16_t*)(wsb + WS_WQ) + o * 256 * 384; break;
    case K_KVUP:  a = (const bf16_t*)(wsb + WS_CKV) + t * 256 * 256; b = (const bf16_t*)(wsb + WS_WKV) + o * 256 * 256; break;
    case K_GMLA:  a = Hb + t * 256 * 1024; b = Win + (WT_GMLA + o) * 256 * 1024; break;
    case K_GRET:  a = Hb + t * 256 * 1024; b = Win + (WT_GRET + o) * 256 * 1024; break;
    case K_P0:    a = Hb + t * 256 * 1024; b = Win + (WT_MMLA + o) * 256 * 1024; break;
    case K_P1:    a = (const bf16_t*)(wsb + WS_O) + t * 256 * 1024; b = (const bf16_t*)(wsb + WS_WPM) + o * 256 * 1024; break;
    case K_P2:    a = Hb + t * 256 * 1024; b = Win + (WT_MRET + o) * 256 * 1024; break;
    case K_P3:    a = (const bf16_t*)outb + t * 256 * 2048; b = (const bf16_t*)(wsb + WS_WPR) + o * 256 * 2048; break;
    default:      a = (const bf16_t*)(wsb + WS_MERGED) + t * 256 * 1024; b = (const bf16_t*)(wsb + WS_WO) + o * 256 * 1024; break;
    }
    A = (const char*)a; B = (const char*)b;
}

__device__ __forceinline__ u32x4 pack8f(const f32x4 a, const f32x4 b) { u32x4 w; w.x = cvt_pk_bf16(a[0], a[1]); w.y = cvt_pk_bf16(a[2], a[3]); w.z = cvt_pk_bf16(b[0], b[1]); w.w = cvt_pk_bf16(b[2], b[3]); return w; }
__device__ __forceinline__ void unpack8(const u32x4 w, f32x4& a, f32x4& b) { a[0] = bflo(w.x); a[1] = bfhi(w.x); a[2] = bflo(w.y); a[3] = bfhi(w.y); b[0] = bflo(w.z); b[1] = bfhi(w.z); b[2] = bflo(w.w); b[3] = bfhi(w.w); }

struct EpiP { int kind, hf, nk; };
#define PIN8(a) asm volatile("" : "+v"(a[0]), "+v"(a[1]), "+v"(a[2]), "+v"(a[3]), "+v"(a[4]), "+v"(a[5]), "+v"(a[6]), "+v"(a[7]))
__device__ __forceinline__ void epilogue(const GCall& g0, const Ctx& X0, f32x4 (&acc)[2][2][4][2], const Unit& u, int wr, int wc, int fr, int fq) {
    size_t z_ = 0; asm volatile("" : "+s"(z_));
    struct { unsigned char* ws; float* out; } X = {X0.ws + z_, X0.out + z_}; EpiP g = {g0.kind, g0.hf, g0.nk};
    asm volatile("" : "+s"(g.kind), "+s"(g.hf), "+s"(g.nk), "+s"(wr), "+s"(wc), "+v"(fr), "+v"(fq));
    const int t = u.t, o = u.o;
    const int* const posp = INI(I_POS);
    const int cl0 = 32 * wc + 8 * fq;
    const int rl0 = 64 * wr + fr;
    switch (g.kind) {
    case K_QK: {
        const int h = o & 3; const bool isk = o >= 4; const float l2g = l2gamma(h);
        float invf[8];
#pragma unroll
        for (int j = 0; j < 8; ++j) invf[j] = INVF[cl0 + j];
        PIN8(invf);
        bf16_t* dst = isk ? ((bf16_t*)X.out + (size_t)h * SEQ * 256) : ((bf16_t*)(X.ws + WS_AQ) + (size_t)h * SEQ * 512 + 256);
        const int pitch = isk ? 256 : 512;
        int posv[2][4];
#pragma unroll
        for (int ai = 0; ai < 2; ++ai)
#pragma unroll
            for (int m = 0; m < 4; ++m) posv[ai][m] = posp[256 * t + 128 * ai + 16 * m + rl0];
#pragma unroll
        for (int ai = 0; ai < 2; ++ai)
#pragma unroll
            for (int m = 0; m < 4; ++m) {
                const int rl = 128 * ai + 16 * m + rl0, tok = 256 * t + rl;
                const float posf = (float)posv[ai][m];
                const float sc = isk ? 0.0625f * fast_exp2((float)(255 - rl) * l2g) : 1.0f;
                f32x4 o1[2], o2[2];
#pragma unroll
                for (int n = 0; n < 2; ++n)
#pragma unroll
                    for (int j = 0; j < 4; ++j) { float s, c; sincos_ang(posf * invf[4 * n + j], s, c); const float x1 = acc[ai][0][m][n][j], x2 = acc[ai][1][m][n][j];
                        o1[n][j] = (x1 * c - x2 * s) * sc; o2[n][j] = (x2 * c + x1 * s) * sc; }
                bf16_t* p = dst + (size_t)tok * pitch + cl0;
                *(u32x4*)p = pack8f(o1[0], o1[1]); *(u32x4*)(p + 128) = pack8f(o2[0], o2[1]);
                if (isk) {
                    bf16_t* kzt = (bf16_t*)(X.ws + WS_KZT) + (size_t)h * 256 * SEQ; const bool odd = fr & 1; const int tokp = tok & ~1;
#pragma unroll
                    for (int hb = 0; hb < 2; ++hb)
#pragma unroll
                        for (int n = 0; n < 2; ++n)
#pragma unroll
                            for (int j = 0; j < 4; j += 2) { const float a = hb ? o2[n][j] : o1[n][j], b = hb ? o2[n][j + 1] : o1[n][j + 1];
                                const float recv = __shfl_xor(odd ? a : b, 1);
                                const int d = 128 * hb + cl0 + 4 * n + j + (odd ? 1 : 0);
                                *(unsigned*)(kzt + (size_t)d * SEQ + tokp) = odd ? cvt_pk_bf16(recv, b) : cvt_pk_bf16(a, recv); }
                }
            }
    } break;
    case K_TRANS: {
        {
            const int hh = o - g.nk; bf16_t* dst = (bf16_t*)(X.ws + WS_VRH);
#pragma unroll
            for (int ai = 0; ai < 2; ++ai)
#pragma unroll
                for (int m = 0; m < 4; ++m) { const int e = 128 * ai + 16 * m + rl0; bf16_t* p = dst + ((size_t)(hh * 256 + e) * 64 + t) * 512 + cl0;
#pragma unroll
                    for (int bj = 0; bj < 2; ++bj) *(u32x4*)(p + 128 * bj) = pack8f(acc[ai][bj][m][0], acc[ai][bj][m][1]); }
        }
    } break;
    case K_S: {
        const int h = o; const float ginv = fast_exp2(-256.0f * l2gamma(h));
        bf16_t* dst = (bf16_t*)(X.ws + WS_AQ) + ((size_t)h * SEQ + 256 * t) * 512;
#pragma unroll
        for (int ai = 0; ai < 2; ++ai)
#pragma unroll
            for (int m = 0; m < 4; ++m) { const int i = 128 * ai + 16 * m + rl0;
#pragma unroll
                for (int bj = 0; bj < 2; ++bj) { const int j0 = 128 * bj + cl0; f32x4 v[2];
#pragma unroll
                    for (int n = 0; n < 2; ++n)
#pragma unroll
                        for (int j = 0; j < 4; ++j) v[n][j] = (j0 + 4 * n + j <= i) ? acc[ai][bj][m][n][j] * ginv : 0.0f;
                    *(u32x4*)(dst + (size_t)i * 512 + j0) = pack8f(v[0], v[1]); } }
    } break;
    case K_U: {
        const int h = o; bf16_t* dst = (bf16_t*)(X.ws + WS_VRH);
#pragma unroll
        for (int ai = 0; ai < 2; ++ai)
#pragma unroll
            for (int m = 0; m < 4; ++m) { const int e = 128 * ai + 16 * m + rl0; bf16_t* p = dst + ((size_t)(h * 256 + e) * 64 + t) * 512 + 256 + cl0;
#pragma unroll
                for (int bj = 0; bj < 2; ++bj) *(u32x4*)(p + 128 * bj) = pack8f(acc[ai][bj][m][0], acc[ai][bj][m][1]); }
    } break;
    case K_MAIN: {
        const int h = o; const float l2g = l2gamma(h);
        bf16_t* dst = (bf16_t*)X.out; f32x2* stat = (f32x2*)(X.ws + WS_STAT);
#pragma unroll
        for (int ai = 0; ai < 2; ++ai)
#pragma unroll
            for (int m = 0; m < 4; ++m) { const int i = 128 * ai + 16 * m + rl0, tok = 256 * t + i; const float xi = fast_exp2((float)(i + 1) * l2g);
                float s = 0.f, ss = 0.f;
#pragma unroll
                for (int bj = 0; bj < 2; ++bj) { f32x4 v0 = acc[ai][bj][m][0] * xi, v1 = acc[ai][bj][m][1] * xi;
#pragma unroll
                    for (int j = 0; j < 4; ++j) { s += v0[j] + v1[j]; ss += v0[j] * v0[j] + v1[j] * v1[j]; }
                    *(u32x4*)(dst + (size_t)tok * 2048 + h * 512 + g.hf * 256 + 128 * bj + cl0) = pack8f(v0, v1); }
                s += __shfl_xor(s, 16); s += __shfl_xor(s, 32); ss += __shfl_xor(ss, 16); ss += __shfl_xor(ss, 32);
                if (fq == 0) stat[(((size_t)tok * 4 + h) * 2 + g.hf) * 4 + wc] = (f32x2){s, ss};
            }
        if (g.hf == 1 && (wr | wc | fr | fq) == 0) __hip_atomic_fetch_add((unsigned*)(X.ws + WS_CTL) + CW_WAR, 1u, __ATOMIC_RELAXED, __HIP_MEMORY_SCOPE_AGENT);
    } break;
    case K_LOW: {
        bf16_t* CQ = (bf16_t*)(X.ws + WS_CQ); bf16_t* CKV = (bf16_t*)(X.ws + WS_CKV); bf16_t* KR = (bf16_t*)(X.ws + WS_KROPE); float* psq = (float*)(X.ws + WS_PSQ);
        int posv[2][4]; float fv[4];
        { const bool pe = (o == 2) && (cl0 < 64);
#pragma unroll
          for (int jj = 0; jj < 4; ++jj) fv[jj] = INVF[4 * (((cl0 & 63) >> 1) + jj)];
#pragma unroll
          for (int ai = 0; ai < 2; ++ai)
#pragma unroll
              for (int m = 0; m < 4; ++m) posv[ai][m] = pe ? posp[256 * t + 128 * ai + 16 * m + rl0] : 0;
          asm volatile("" : "+v"(fv[0]), "+v"(fv[1]), "+v"(fv[2]), "+v"(fv[3]), "+v"(posv[0][0]), "+v"(posv[0][1]), "+v"(posv[0][2]), "+v"(posv[0][3]), "+v"(posv[1][0]), "+v"(posv[1][1]), "+v"(posv[1][2]), "+v"(posv[1][3])); }
#pragma unroll
        for (int ai = 0; ai < 2; ++ai)
#pragma unroll
            for (int m = 0; m < 4; ++m) { const int tok = 256 * t + 128 * ai + 16 * m + rl0;
#pragma unroll
                for (int bj = 0; bj < 2; ++bj) { const int gcol = 256 * o + 128 * bj + cl0; const f32x4 v0 = acc[ai][bj][m][0], v1 = acc[ai][bj][m][1];
                    if (gcol < 640) {
                        float ss = 0.f;
#pragma unroll
                        for (int j = 0; j < 4; ++j) ss += v0[j] * v0[j] + v1[j] * v1[j];
                        ss += __shfl_xor(ss, 16); ss += __shfl_xor(ss, 32);
                        if (fq == 0) psq[(size_t)tok * 24 + (gcol >> 5)] = ss;
                        bf16_t* p = (gcol < 384) ? (CQ + (size_t)tok * 384 + gcol) : (CKV + (size_t)tok * 256 + (gcol - 384));
                        *(u32x4*)p = pack8f(v0, v1);
                    } else if (gcol < 704) {
                        const int i0 = (gcol - 640) >> 1; const float posf = (float)posv[ai][m]; f32x4 o1, o2;
#pragma unroll
                        for (int jj = 0; jj < 4; ++jj) { const float x1 = jj < 2 ? v0[2 * jj] : v1[2 * jj - 4], x2 = jj < 2 ? v0[2 * jj + 1] : v1[2 * jj - 3];
                            float s, c; sincos_ang(posf * fv[jj], s, c); o1[jj] = x1 * c - x2 * s; o2[jj] = x2 * c + x1 * s; }
                        u32x2 w1, w2; w1.x = cvt_pk_bf16(o1[0], o1[1]); w1.y = cvt_pk_bf16(o1[2], o1[3]); w2.x = cvt_pk_bf16(o2[0], o2[1]); w2.y = cvt_pk_bf16(o2[2], o2[3]);
                        *(u32x2*)(KR + (size_t)tok * 64 + i0) = w1; *(u32x2*)(KR + (size_t)tok * 64 + 32 + i0) = w2;
                    }
                } }
    } break;
    case K_QUP: {
        bf16_t* Q = (bf16_t*)(X.ws + WS_Q); const float* psq = (const float*)(X.ws + WS_PSQ);
        float fv[8];
#pragma unroll
        for (int j = 0; j < 8; ++j) fv[j] = INVF[4 * (8 * fq + j)];
        int posv[8];
#pragma unroll
        for (int q = 0; q < 8; ++q) posv[q] = (o >= 4) ? posp[256 * t + 128 * (q >> 2) + 16 * (q & 3) + rl0] : 0;
        PIN8(fv); PIN8(posv);
#pragma unroll
        for (int ai = 0; ai < 2; ++ai) {
            f32x4 sv[4][3];
#pragma unroll
            for (int m = 0; m < 4; ++m) { const int tok = 256 * t + 128 * ai + 16 * m + rl0; const f32x4* sp = (const f32x4*)(psq + (size_t)tok * 24);
                sv[m][0] = sp[0]; sv[m][1] = sp[1]; sv[m][2] = sp[2]; }
#pragma unroll
            for (int m = 0; m < 4; ++m) { const int tok = 256 * t + 128 * ai + 16 * m + rl0; const f32x4 s0 = sv[m][0], s1 = sv[m][1], s2 = sv[m][2];
                const float ssum = ((s0[0] + s0[1]) + (s0[2] + s0[3])) + ((s1[0] + s1[1]) + (s1[2] + s1[3])) + ((s2[0] + s2[1]) + (s2[2] + s2[3]));
                const float rs = __builtin_amdgcn_rsqf(ssum * (1.0f / 384.0f) + EPS) * QSCALE;
                if (o < 4) {
#pragma unroll
                    for (int bj = 0; bj < 2; ++bj) *(u32x4*)(Q + (size_t)tok * 1536 + (2 * o + bj) * 192 + cl0) = pack8f(acc[ai][bj][m][0] * rs, acc[ai][bj][m][1] * rs);
                } else {
                    const int head = (o - 4) * 4 + wc, i0 = 8 * fq; const float posf = (float)posv[4 * ai + m]; f32x4 o1[2], o2[2];
#pragma unroll
                    for (int n = 0; n < 2; ++n)
#pragma unroll
                        for (int j = 0; j < 4; ++j) { float s, c; sincos_ang(posf * fv[4 * n + j], s, c); const float x1 = acc[ai][0][m][n][j] * rs, x2 = acc[ai][1][m][n][j] * rs;
                            o1[n][j] = x1 * c - x2 * s; o2[n][j] = x2 * c + x1 * s; }
                    bf16_t* p = Q + (size_t)tok * 1536 + head * 192 + 128 + i0;
                    *(u32x4*)p = pack8f(o1[0], o1[1]); *(u32x4*)(p + 32) = pack8f(o2[0], o2[1]);
                }
            }
        }
    } break;
    case K_KVUP: {
        bf16_t* Kb = (bf16_t*)(X.ws + WS_K); bf16_t* Vb = (bf16_t*)(X.ws + WS_V); const float* psq = (const float*)(X.ws + WS_PSQ);
        const int tid = (wr * 4 + wc) * 64 + fq * 16 + fr, tokc = 256 * t + (tid >> 1), hsel = tid & 1;
        const u32x4* src = (const u32x4*)((const bf16_t*)(X.ws + WS_KROPE) + (size_t)tokc * 64 + hsel * 32);
        u32x4 rp[4];
#pragma unroll
        for (int q = 0; q < 4; ++q) rp[q] = src[q];
#pragma unroll
        for (int ai = 0; ai < 2; ++ai) {
            f32x4 sv[4][2];
#pragma unroll
            for (int m = 0; m < 4; ++m) { const int tok = 256 * t + 128 * ai + 16 * m + rl0; sv[m][0] = *(const f32x4*)(psq + (size_t)tok * 24 + 12); sv[m][1] = *(const f32x4*)(psq + (size_t)tok * 24 + 16); }
            if (ai == 0) { u32x4* dstp = (u32x4*)(Kb + (size_t)tokc * 1536 + o * 192 + 128 + hsel * 32);
#pragma unroll
                for (int q = 0; q < 4; ++q) dstp[q] = rp[q]; }
#pragma unroll
            for (int m = 0; m < 4; ++m) { const int tok = 256 * t + 128 * ai + 16 * m + rl0; const f32x4 s0 = sv[m][0], s1 = sv[m][1];
                const float ssum = ((s0[0] + s0[1]) + (s0[2] + s0[3])) + ((s1[0] + s1[1]) + (s1[2] + s1[3]));
                const float rs = __builtin_amdgcn_rsqf(ssum * (1.0f / 256.0f) + EPS);
                *(u32x4*)(Kb + (size_t)tok * 1536 + o * 192 + cl0) = pack8f(acc[ai][0][m][0] * rs, acc[ai][0][m][1] * rs);
                *(u32x4*)(Vb + (size_t)tok * 1024 + o * 128 + cl0) = pack8f(acc[ai][1][m][0] * rs, acc[ai][1][m][1] * rs);
            }
        }
    } break;
    case K_GMLA: {
        bf16_t* Ob = (bf16_t*)(X.ws + WS_O);
#pragma unroll
        for (int ai = 0; ai < 2; ++ai) {
            u32x4 ov[4][2];
#pragma unroll
            for (int m = 0; m < 4; ++m)
#pragma unroll
                for (int bj = 0; bj < 2; ++bj) ov[m][bj] = *(const u32x4*)(Ob + (size_t)(256 * t + 128 * ai + 16 * m + rl0) * 1024 + 256 * o + 128 * bj + cl0);
#pragma unroll
            for (int m = 0; m < 4; ++m) { const int tok = 256 * t + 128 * ai + 16 * m + rl0;
#pragma unroll
                for (int bj = 0; bj < 2; ++bj) { bf16_t* p = Ob + (size_t)tok * 1024 + 256 * o + 128 * bj + cl0; f32x4 a, b; unpack8(ov[m][bj], a, b);
#pragma unroll
                    for (int j = 0; j < 4; ++j) { a[j] *= siluf_(acc[ai][bj][m][0][j]); b[j] *= siluf_(acc[ai][bj][m][1][j]); }
                    *(u32x4*)p = pack8f(a, b); } }
        }
        if ((wr | wc) == 0) { const unsigned* ad = (const unsigned*)(X.ws + WS_CTL) + CW_ADONE; unsigned sp = 0;
            while ((unsigned)__builtin_amdgcn_readfirstlane((int)__hip_atomic_load(ad, __ATOMIC_RELAXED, __HIP_MEMORY_SCOPE_AGENT)) < 256u) { __builtin_amdgcn_s_sleep(4); if (++sp > (1u << 22)) break; } }
    } break;
    case K_GRET: {
        const float* const g_retp = INF(I_GRET);
        bf16_t* Ob = (bf16_t*)X.out; const float* stat = (const float*)(X.ws + WS_STAT); const int h = o >> 1;
        f32x4 gv[2][2];
#pragma unroll
        for (int bj = 0; bj < 2; ++bj) { gv[bj][0] = *(const f32x4*)(g_retp + 256 * o + 128 * bj + cl0); gv[bj][1] = *(const f32x4*)(g_retp + 256 * o + 128 * bj + cl0 + 4); }
#pragma unroll
        for (int ai = 0; ai < 2; ++ai)
#pragma unroll
            for (int mp = 0; mp < 2; ++mp) {
                f32x4 sq[2][4]; u32x4 ov[2][2];
#pragma unroll
                for (int mm = 0; mm < 2; ++mm) { const int tok = 256 * t + 128 * ai + 16 * (2 * mp + mm) + rl0; const f32x4* sp = (const f32x4*)(stat + ((size_t)tok * 4 + h) * 16);
                    sq[mm][0] = sp[0]; sq[mm][1] = sp[1]; sq[mm][2] = sp[2]; sq[mm][3] = sp[3];
#pragma unroll
                    for (int bj = 0; bj < 2; ++bj) ov[mm][bj] = *(const u32x4*)(Ob + (size_t)tok * 2048 + 256 * o + 128 * bj + cl0); }
#pragma unroll
                for (int mm = 0; mm < 2; ++mm) { const int m = 2 * mp + mm, tok = 256 * t + 128 * ai + 16 * m + rl0; const f32x4 q0 = sq[mm][0], q1 = sq[mm][1], q2 = sq[mm][2], q3 = sq[mm][3];
                    const float s = ((q0[0] + q0[2]) + (q1[0] + q1[2])) + ((q2[0] + q2[2]) + (q3[0] + q3[2])), ss = ((q0[1] + q0[3]) + (q1[1] + q1[3])) + ((q2[1] + q2[3]) + (q3[1] + q3[3]));
                    const float mean = s * (1.0f / 512.0f); const float var = __builtin_fmaxf(ss * (1.0f / 512.0f) - mean * mean, 0.0f); const float rstd = __builtin_amdgcn_rsqf(var + EPS);
#pragma unroll
                    for (int bj = 0; bj < 2; ++bj) { bf16_t* p = Ob + (size_t)tok * 2048 + 256 * o + 128 * bj + cl0; f32x4 a, b; unpack8(ov[mm][bj], a, b);
#pragma unroll
                        for (int j = 0; j < 4; ++j) { a[j] = (a[j] - mean) * rstd * gv[bj][0][j] * siluf_(acc[ai][bj][m][0][j]); b[j] = (b[j] - mean) * rstd * gv[bj][1][j] * siluf_(acc[ai][bj][m][1][j]); }
                        *(u32x4*)p = pack8f(a, b); } }
            }
    } break;
    case K_P0: case K_P2: case K_P1: case K_P3: {
        const int tid = (wr * 4 + wc) * 64 + fq * 16 + fr; const size_t so = (size_t)blockIdx.x * 16 * 512 + tid;
        u32x4* sa1 = (u32x4*)(X.ws + WS_SCRA) + so; u32x4* sb = (u32x4*)(X.ws + WS_SCRB) + so; u32x4* sa2 = (u32x4*)(X.ws + WS_SCRA2) + so;
        bf16_t* Mg = (bf16_t*)(X.ws + WS_MERGED);
        if (g.kind == K_P0 || g.kind == K_P2) {
            u32x4* sa = (g.kind == K_P0) ? sa1 : sa2;
#pragma unroll
            for (int ai = 0; ai < 2; ++ai)
#pragma unroll
                for (int bj = 0; bj < 2; ++bj)
#pragma unroll
                    for (int m = 0; m < 4; ++m) { const int rj = (ai * 2 + bj) * 4 + m; const f32x4 a = acc[ai][bj][m][0], b = acc[ai][bj][m][1]; u32x4 w;
                        w.x = cvt_pk_bf16(sigmoidf_(a[0]), sigmoidf_(a[1])); w.y = cvt_pk_bf16(sigmoidf_(a[2]), sigmoidf_(a[3]));
                        w.z = cvt_pk_bf16(sigmoidf_(b[0]), sigmoidf_(b[1])); w.w = cvt_pk_bf16(sigmoidf_(b[2]), sigmoidf_(b[3])); sa[(size_t)rj * 512] = w; }
        } else {
            const u32x4* sa = (g.kind == K_P1) ? sa1 : sa2;
#pragma unroll
            for (int ai = 0; ai < 2; ++ai) {
                u32x4 gw[2][4], tv[2][4];
#pragma unroll
                for (int bj = 0; bj < 2; ++bj)
#pragma unroll
                    for (int m = 0; m < 4; ++m) { const int rj = (ai * 2 + bj) * 4 + m; gw[bj][m] = sa[(size_t)rj * 512]; if (g.kind == K_P3) tv[bj][m] = sb[(size_t)rj * 512]; }
#pragma unroll
                for (int bj = 0; bj < 2; ++bj)
#pragma unroll
                    for (int m = 0; m < 4; ++m) { const int rj = (ai * 2 + bj) * 4 + m; f32x4 g0, g1; unpack8(gw[bj][m], g0, g1);
                        const f32x4 p0 = g0 * acc[ai][bj][m][0], p1 = g1 * acc[ai][bj][m][1];
                        if (g.kind == K_P1) sb[(size_t)rj * 512] = pack8f(p0, p1);
                        else { f32x4 t0, t1; unpack8(tv[bj][m], t0, t1); const int tok = 256 * t + 128 * ai + 16 * m + rl0;
                            *(u32x4*)(Mg + (size_t)tok * 1024 + 256 * o + 128 * bj + cl0) = pack8f(t0 + p0, t1 + p1); } }
            }
        }
    } break;
    default: break;
    }
}

__device__ __forceinline__ void epilogue_final(const Ctx& X0, f32x4 (&acc)[2][2][4][2], const Unit& u, int wr, int wc, int fr, int fq, LAS unsigned char* lds) {
    size_t z_ = 0; asm volatile("" : "+s"(z_));
    struct { unsigned char* ws; float* out; } X = {X0.ws + z_, X0.out + z_};
    asm volatile("" : "+s"(wr), "+s"(wc), "+v"(fr), "+v"(fq));
    const int t = u.t, o = u.o, cl0 = 32 * wc + 8 * fq, rl0 = 64 * wr + fr, tid = (wr * 4 + wc) * 64 + fq * 16 + fr;
    const float* const xp = INF(I_X);
    const float* gate = (const float*)(X.ws + WS_MOD) + 2048; float* fsq = (float*)(X.ws + WS_FSQ);
    unsigned* cnt = (unsigned*)(X.ws + WS_CTL) + CW_CNT + 64 * t;
    LAS u32x2* slot = (LAS u32x2*)lds + tid;
    { f32x4 gv[2][2];
#pragma unroll
    for (int bj = 0; bj < 2; ++bj) { gv[bj][0] = *(const f32x4*)(gate + 256 * o + 128 * bj + cl0); gv[bj][1] = *(const f32x4*)(gate + 256 * o + 128 * bj + cl0 + 4); }
    f32x4 xv[2][2][2][2];
#define XLOAD(b_) do { _Pragma("unroll") for (int mm = 0; mm < 2; ++mm) _Pragma("unroll") for (int bj = 0; bj < 2; ++bj) _Pragma("unroll") for (int n = 0; n < 2; ++n) \
        xv[(b_) & 1][mm][bj][n] = *(const f32x4*)(xp + (size_t)(256 * t + 128 * ((b_) >> 1) + 16 * (2 * ((b_) & 1) + mm) + rl0) * 1024 + 256 * o + 128 * bj + cl0 + 4 * n); } while (0)
    XLOAD(0);
#pragma unroll
    for (int b = 0; b < 4; ++b) { const int ai = b >> 1, mp = b & 1;
        if (b + 1 < 4) XLOAD(b + 1);
#pragma unroll
        for (int mm = 0; mm < 2; ++mm) { const int m = 2 * mp + mm, tok = 256 * t + 128 * ai + 16 * m + rl0; float ss = 0.f;
#pragma unroll
            for (int bj = 0; bj < 2; ++bj)
#pragma unroll
                for (int n = 0; n < 2; ++n) {
                    const f32x4 v = xv[b & 1][mm][bj][n] + gv[bj][n] * acc[ai][bj][m][n]; u32x2 w; w.x = cvt_pk_bf16(v[0], v[1]); w.y = cvt_pk_bf16(v[2], v[3]);
                    const f32x4 vr = {bflo(w.x), bfhi(w.x), bflo(w.y), bfhi(w.y)};
                    ss += (vr[0] * vr[0] + vr[1] * vr[1]) + (vr[2] * vr[2] + vr[3] * vr[3]); slot[(((ai * 2 + bj) * 4 + m) * 2 + n) * 512] = w; }
            ss += __shfl_xor(ss, 16); ss += __shfl_xor(ss, 32);
            if (fq == 0) __hip_atomic_store(fsq + (size_t)tok * 16 + 4 * o + wc, ss, __ATOMIC_RELAXED, __HIP_MEMORY_SCOPE_AGENT); } }
#undef XLOAD
    }
    asm volatile("s_waitcnt vmcnt(0)" ::: "memory");
    if (fq == 0 && fr == 0) __hip_atomic_fetch_add(cnt, 1u, __ATOMIC_RELAXED, __HIP_MEMORY_SCOPE_AGENT);
    { unsigned sp = 0;
      while ((unsigned)__builtin_amdgcn_readfirstlane((int)__hip_atomic_load(cnt, __ATOMIC_RELAXED, __HIP_MEMORY_SCOPE_AGENT)) < 32u) { __builtin_amdgcn_s_sleep(4); if (++sp > (1u << 22)) break; } }
    __builtin_amdgcn_fence(__ATOMIC_ACQUIRE, "agent");
    { const float* const gfin = INF(I_GFINAL);
    f32x4 gf[2][2];
#pragma unroll
    for (int bj = 0; bj < 2; ++bj) { gf[bj][0] = *(const f32x4*)(gfin + 256 * o + 128 * bj + cl0); gf[bj][1] = *(const f32x4*)(gfin + 256 * o + 128 * bj + cl0 + 4); }
    float rstd[2][4];
    { f32x4 fv[2][4][4];
#pragma unroll
      for (int ai = 0; ai < 2; ++ai)
#pragma unroll
          for (int m = 0; m < 4; ++m) { const f32x4* sp = (const f32x4*)(fsq + (size_t)(256 * t + 128 * ai + 16 * m + rl0) * 16); fv[ai][m][0] = sp[0]; fv[ai][m][1] = sp[1]; fv[ai][m][2] = sp[2]; fv[ai][m][3] = sp[3]; }
#pragma unroll
      for (int ai = 0; ai < 2; ++ai)
#pragma unroll
          for (int m = 0; m < 4; ++m) { const f32x4 a = fv[ai][m][0], b = fv[ai][m][1], c = fv[ai][m][2], d = fv[ai][m][3];
              const float ss = (((a[0] + a[1]) + (a[2] + a[3])) + ((b[0] + b[1]) + (b[2] + b[3]))) + (((c[0] + c[1]) + (c[2] + c[3])) + ((d[0] + d[1]) + (d[2] + d[3])));
              rstd[ai][m] = __builtin_amdgcn_rsqf(ss * (1.0f / DM) + EPS); } }
#pragma unroll
    for (int ai = 0; ai < 2; ++ai)
#pragma unroll
        for (int m = 0; m < 4; ++m) { const int tok = 256 * t + 128 * ai + 16 * m + rl0;
#pragma unroll
            for (int bj = 0; bj < 2; ++bj)
#pragma unroll
                for (int n = 0; n < 2; ++n) { const u32x2 w = slot[(((ai * 2 + bj) * 4 + m) * 2 + n) * 512]; const f32x4 v = {bflo(w.x), bfhi(w.x), bflo(w.y), bfhi(w.y)};
                    *(f32x4*)(X.out + (size_t)tok * 1024 + 256 * o + 128 * bj + cl0 + 4 * n) = v * rstd[ai][m] * gf[bj][n]; }
            asm volatile("" ::: "memory"); } }
}

struct Step;
__device__ __forceinline__ GCall step_call(int si);
__device__ __forceinline__ void gemm_stream(LAS unsigned char* lds, int s0, int ns, const Ctx& X) {
    const int tid = X.tid, wid = __builtin_amdgcn_readfirstlane(tid >> 6), lane = tid & 63, wr = wid >> 2, wc = wid & 3, fr = lane & 15, fq = lane >> 4;
#define PG8_VOFF(VA, VB, lda_, ldb_) do { int t_ = tid; asm volatile("" : "+v"(t_)); _Pragma("unroll") for (int i = 0; i < 2; ++i) { int R_, C_; stage_rc(t_ * 16 + i * 8192, R_, C_); \
        const int Rb_ = (R_ & ~31) + perm32(R_ & 31); VA[i] = (unsigned)(R_ * (lda_) + C_) * 2u; VB[i] = (unsigned)(Rb_ * (ldb_) + C_) * 2u; } } while (0)
    const size_t kstep = (size_t)(BK * 2);
    const unsigned ldsw = (unsigned)wid * 1024u;
    const int aoff = lds_byte(wr * 64 + fr, fq * 8), boff = lds_byte(wc * 32 + fr, fq * 8);
#define PG8_SA(b, h) (((b) * 2 + (h)) * HTB)
#define PG8_SB(b, h) ((4 + (b) * 2 + (h)) * HTB)
#define PG8_STAGE(bufoff, gbase, voff) do { _Pragma("unroll") for (int _i = 0; _i < 2; ++_i) \
        __builtin_amdgcn_global_load_lds((const unsigned*)((const char*)(gbase) + (voff)[_i]), (LAS unsigned*)(lds + (bufoff) + ldsw + _i * 8192), 16, 0, 0); } while (0)
#define PG8_LDA(dst, b, h) do { _Pragma("unroll") for (int m = 0; m < 4; ++m) _Pragma("unroll") for (int k = 0; k < 2; ++k) dst[m][k] = *(const LAS bf16x8*)(lds + PG8_SA(b, h) + aoff + m * 2048 + k * 1024); } while (0)
#define PG8_LDB(dst, b, h) do { _Pragma("unroll") for (int n = 0; n < 2; ++n) _Pragma("unroll") for (int k = 0; k < 2; ++k) dst[n][k] = *(const LAS bf16x8*)(lds + PG8_SB(b, h) + boff + n * 2048 + k * 1024); } while (0)
#define PG8_MMA(ai, bj, At, Bt) do { __builtin_amdgcn_s_setprio(1); _Pragma("unroll") for (int m = 0; m < 4; ++m) _Pragma("unroll") for (int n = 0; n < 2; ++n) _Pragma("unroll") for (int k = 0; k < 2; ++k) \
        acc[ai][bj][m][n] = __builtin_amdgcn_mfma_f32_16x16x32_bf16(Bt[n][k], At[m][k], acc[ai][bj][m][n], 0, 0, 0); __builtin_amdgcn_s_setprio(0); } while (0)
#define PG8_WAIT_V(n) asm volatile("s_waitcnt vmcnt(" #n ")" ::: "memory")
#define PG8_WAIT_L(n) asm volatile("s_waitcnt lgkmcnt(" #n ")" ::: "memory")
#define PG8_BAR __builtin_amdgcn_s_barrier()
#define PG8_SCHED __builtin_amdgcn_sched_barrier(0)
#define PG8_KBODY(a1, a2, a3, b2, b3, VA2, VB2, HA2, HB2) do { \
        PG8_LDB(B0, 0, 0); PG8_LDB(B1, 0, 1); PG8_SCHED; PG8_LDA(At, 0, 0); PG8_STAGE(PG8_SA(1, 1), (a1) + hstepA, voffA); \
        PG8_WAIT_V(8); PG8_WAIT_L(0); PG8_BAR; PG8_MMA(0, 0, At, B0); PG8_MMA(0, 1, At, B1); PG8_BAR; PG8_SCHED; \
        PG8_LDA(At, 0, 1); PG8_STAGE(PG8_SB(0, 0), (b2), VB2); PG8_STAGE(PG8_SB(0, 1), (b2) + (HB2), VB2); PG8_STAGE(PG8_SA(0, 0), (a2), VA2); \
        PG8_WAIT_V(8); PG8_WAIT_L(0); PG8_BAR; PG8_MMA(1, 0, At, B0); PG8_MMA(1, 1, At, B1); PG8_BAR; PG8_SCHED; \
        PG8_LDB(B0, 1, 0); PG8_LDB(B1, 1, 1); PG8_SCHED; PG8_LDA(At, 1, 0); PG8_STAGE(PG8_SA(0, 1), (a2) + (HA2), VA2); \
        PG8_WAIT_V(8); PG8_WAIT_L(0); PG8_BAR; PG8_MMA(0, 0, At, B0); PG8_MMA(0, 1, At, B1); PG8_BAR; PG8_SCHED; \
        PG8_LDA(At, 1, 1); PG8_STAGE(PG8_SB(1, 0), (b3), VB2); PG8_STAGE(PG8_SB(1, 1), (b3) + (HB2), VB2); PG8_STAGE(PG8_SA(1, 0), (a3), VA2); \
        PG8_WAIT_V(8); PG8_WAIT_L(0); PG8_BAR; PG8_MMA(1, 0, At, B0); PG8_MMA(1, 1, At, B1); PG8_BAR; PG8_SCHED; } while (0)
    int seg = 0, ui = 0; GCall g = step_call(s0); Unit cur;
    while (!unit_next(g, X.vcu, ui, cur)) { if (++seg >= ns) return; g = step_call(s0 + seg); ui = 0; }
    unsigned voffA[2], voffB[2], nvoffA[2], nvoffB[2];
    PG8_VOFF(voffA, voffB, g.lda, g.ldb);
    size_t hstepA = (size_t)HALF * g.lda * 2, hstepB = (size_t)HALF * g.ldb * 2;
    int nt = g.K / BK;
    f32x4 acc[2][2][4][2];
#pragma unroll
    for (int a = 0; a < 2; ++a)
#pragma unroll
        for (int b = 0; b < 2; ++b)
#pragma unroll
            for (int m = 0; m < 4; ++m)
#pragma unroll
                for (int n = 0; n < 2; ++n) acc[a][b][m][n] = (f32x4){0.f, 0.f, 0.f, 0.f};
    bf16x8 At[4][2], B0[2][2], B1[2][2];
    const char* cA; const char* cB; unit_ptrs(g, X, cur, cA, cB);
    PG8_STAGE(PG8_SB(0, 0), cB, voffB); PG8_STAGE(PG8_SB(0, 1), cB + hstepB, voffB); PG8_STAGE(PG8_SA(0, 0), cA, voffA); PG8_STAGE(PG8_SA(0, 1), cA + hstepA, voffA);
    if (wr == 1) PG8_BAR;
    PG8_WAIT_V(2); PG8_BAR;
    PG8_STAGE(PG8_SB(1, 0), cB + kstep, voffB); PG8_STAGE(PG8_SA(1, 0), cA + kstep, voffA); PG8_STAGE(PG8_SB(1, 1), cB + hstepB + kstep, voffB);
    PG8_WAIT_V(6); PG8_BAR;
    for (;;) {
        GCall ng = g; Unit nxt; int nseg = seg, nui = ui + 1; bool has_next = true;
        while (!unit_next(ng, X.vcu, nui, nxt)) { if (++nseg >= ns) { has_next = false; break; } ng = step_call(s0 + nseg); nui = 0; }
        const char* nA = cA; const char* nB = cB; size_t nhstepA = hstepA, nhstepB = hstepB;
#pragma unroll
        for (int i = 0; i < 2; ++i) { nvoffA[i] = voffA[i]; nvoffB[i] = voffB[i]; }
        if (has_next) { unit_ptrs(ng, X, nxt, nA, nB); nhstepA = (size_t)HALF * ng.lda * 2; nhstepB = (size_t)HALF * ng.ldb * 2;
            if (nseg != seg) PG8_VOFF(nvoffA, nvoffB, ng.lda, ng.ldb); }
        for (int t = 0; t < nt - 2; t += 2) {
            const char* a1 = cA + (size_t)(t + 1) * kstep; const char* a2 = cA + (size_t)(t + 2) * kstep; const char* b2 = cB + (size_t)(t + 2) * kstep;
            PG8_KBODY(a1, a2, a2 + kstep, b2, b2 + kstep, voffA, voffB, hstepA, hstepB);
        }
        { const char* a1 = cA + (size_t)(nt - 1) * kstep;
          PG8_KBODY(a1, nA, nA + kstep, nB, nB + kstep, nvoffA, nvoffB, nhstepA, nhstepB); }
        if (wr == 0) PG8_BAR;
        if (g.kind != K_FINAL) epilogue(g, X, acc, cur, wr, wc, fr, fq);
        if (!has_next) break;
#pragma unroll
        for (int a = 0; a < 2; ++a)
#pragma unroll
            for (int b = 0; b < 2; ++b)
#pragma unroll
                for (int m = 0; m < 4; ++m)
#pragma unroll
                    for (int n = 0; n < 2; ++n) acc[a][b][m][n] = (f32x4){0.f, 0.f, 0.f, 0.f};
        cur = nxt; cA = nA; cB = nB; g = ng; seg = nseg; ui = nui; hstepA = nhstepA; hstepB = nhstepB; nt = g.K / BK;
#pragma unroll
        for (int i = 0; i < 2; ++i) { voffA[i] = nvoffA[i]; voffB[i] = nvoffB[i]; }
        if (wr == 1) PG8_BAR;
    }
    PG8_WAIT_V(0);
    PG8_BAR;
    if (g.kind == K_FINAL) epilogue_final(X, acc, cur, wr, wc, fr, fq, lds);
#undef PG8_KBODY
#undef PG8_VOFF
#undef PG8_SA
#undef PG8_SB
#undef PG8_STAGE
#undef PG8_LDA
#undef PG8_LDB
#undef PG8_MMA
#undef PG8_WAIT_V
#undef PG8_WAIT_L
#undef PG8_BAR
#undef PG8_SCHED
}

namespace att16 {
constexpr int QP = 1536, VP = 1024, OP = 1024;
constexpr int KROWB = 416, VROWB = 288;
constexpr int SHM_K = 64 * KROWB, SHM_V = 64 * VROWB;
constexpr int LDS_V = 0, LDS_K = 2 * SHM_V, LDS_TOTAL = LDS_K + 2 * SHM_K;
constexpr float THR2 = 11.5f;
typedef __attribute__((address_space(3))) const char* lds_cptr;
typedef short v4i16_t __attribute__((ext_vector_type(4)));
#define SBAR() __builtin_amdgcn_sched_barrier(0)
__device__ __forceinline__ s16x4 vtr(lds_cptr p) { return __builtin_bit_cast(s16x4, __builtin_amdgcn_ds_read_tr16_b64_v4i16((__attribute__((address_space(3))) v4i16_t*)p)); }
__device__ __forceinline__ bf16x8 kfr(lds_cptr p) { return *(const __attribute__((address_space(3))) bf16x8*)p; }
__device__ __forceinline__ float xmax16(float x) {
    auto r = __builtin_amdgcn_permlane16_swap(__float_as_uint(x), __float_as_uint(x), false, false); x = fmaxf(__uint_as_float(r[0]), __uint_as_float(r[1]));
    auto r2 = __builtin_amdgcn_permlane32_swap(__float_as_uint(x), __float_as_uint(x), false, false); return fmaxf(__uint_as_float(r2[0]), __uint_as_float(r2[1]));
}
__device__ __forceinline__ float xsum16(float x) {
    auto r = __builtin_amdgcn_permlane16_swap(__float_as_uint(x), __float_as_uint(x), false, false); x = __uint_as_float(r[0]) + __uint_as_float(r[1]);
    auto r2 = __builtin_amdgcn_permlane32_swap(__float_as_uint(x), __float_as_uint(x), false, false); return __uint_as_float(r2[0]) + __uint_as_float(r2[1]);
}
#define MM16(acc_, a_, b_) acc_ = __builtin_amdgcn_mfma_f32_16x16x32_bf16(a_, b_, acc_, 0, 0, 0)
__device__ __forceinline__ void attn_unit(const bf16_t* Qh, const bf16_t* Kh, const bf16_t* Vh, bf16_t* Oh, int q0, char* lds, int tid) {
    asm volatile("" : "+v"(tid));
    const int wid = __builtin_amdgcn_readfirstlane(tid >> 6), lane = tid & 63, c = lane & 15, g = lane >> 4;
    const int NT = (q0 + 256) / 64;
    const int qlo = q0 + wid * 32;
    char* V_lds = lds + LDS_V; char* K_lds = lds + LDS_K;
    const int sr = tid >> 4, sc = (tid & 15) * 8, vst0 = sr * VROWB + sc * 2;
    int krc[3];
#pragma unroll
    for (int i = 0; i < 3; ++i) { const int q = tid + 512 * i, row = q / 24, cc = q - row * 24; krc[i] = (row << 5) | cc; }
    const lds_cptr l3 = (lds_cptr)lds;
    const lds_cptr kp0 = l3 + LDS_K + c * KROWB + g * 16;
    const lds_cptr vp0 = l3 + LDS_V + (4 * g + (c >> 2)) * VROWB + 8 * (c & 3);
    bf16x8 qf[2][6];
#pragma unroll
    for (int qb = 0; qb < 2; ++qb)
#pragma unroll
        for (int ks = 0; ks < 6; ++ks) qf[qb][ks] = *reinterpret_cast<const bf16x8*>(Qh + (size_t)(qlo + 16 * qb + c) * QP + 32 * ks + 8 * g);
    bf16x8 sa0, sa1, sa2, sb0, sb1, sb2, sv0, sv1;
#define KOFF(i, rowmul, ccmul) ({ int k_ = krc[i]; asm volatile("" : "+v"(k_)); (k_ >> 5) * (rowmul) + (k_ & 31) * (ccmul); })
#define KLOAD(tt, k0_, k1_, k2_) do { const bf16_t* kp_ = Kh + (size_t)(tt) * 64 * QP; \
        k0_ = *reinterpret_cast<const bf16x8*>(kp_ + KOFF(0, QP, 8)); k1_ = *reinterpret_cast<const bf16x8*>(kp_ + KOFF(1, QP, 8)); k2_ = *reinterpret_cast<const bf16x8*>(kp_ + KOFF(2, QP, 8)); } while (0)
#define VLOAD(tt) do { const bf16_t* vp_ = Vh + (size_t)(tt) * 64 * VP + (size_t)sr * VP + sc; sv0 = *reinterpret_cast<const bf16x8*>(vp_); sv1 = *reinterpret_cast<const bf16x8*>(vp_ + 32 * VP); } while (0)
#define KWRITE(ko, k0_, k1_, k2_) do { *(bf16x8*)(K_lds + (ko) + KOFF(0, KROWB, 16)) = k0_; *(bf16x8*)(K_lds + (ko) + KOFF(1, KROWB, 16)) = k1_; *(bf16x8*)(K_lds + (ko) + KOFF(2, KROWB, 16)) = k2_; } while (0)
#define VWRITE(vo) do { *(bf16x8*)(V_lds + (vo) + vst0) = sv0; *(bf16x8*)(V_lds + (vo) + vst0 + 32 * VROWB) = sv1; } while (0)
    float m_reg[2] = {0.f, 0.f}, l_reg[2] = {0.f, 0.f};
    f32x4 o[8][2];
#pragma unroll
    for (int db = 0; db < 8; ++db) { o[db][0] = (f32x4){0.f, 0.f, 0.f, 0.f}; o[db][1] = (f32x4){0.f, 0.f, 0.f, 0.f}; }
    KLOAD(0, sa0, sa1, sa2); VLOAD(0); KWRITE(0, sa0, sa1, sa2); VWRITE(0); KLOAD(1, sa0, sa1, sa2); VLOAD(1); KLOAD(2, sb0, sb1, sb2); __syncthreads();
    int kcur = 0, vcur = 0;
#define ASTEP(t, k0_, k1_, k2_) do { \
        SBAR(); \
        step_s(t); \
        SBAR(); \
        step_pv(t); \
        SBAR(); \
        KWRITE(kcur ^ SHM_K, k0_, k1_, k2_); VWRITE(vcur ^ SHM_V);     \
        KLOAD(min((t) + 3, NT - 1), k0_, k1_, k2_);                       \
        VLOAD(min((t) + 2, NT - 1)); \
        __syncthreads(); \
        kcur ^= SHM_K; vcur ^= SHM_V; } while (0)
    bf16x8 pf[2][2]; bool act;
    auto step_s = [&](int t) __attribute__((always_inline)) {
        act = 64 * t <= qlo + 31;
        if (act) {
        f32x4 s[4][2];
#pragma unroll
        for (int kb = 0; kb < 4; ++kb) { s[kb][0] = (f32x4){-m_reg[0], -m_reg[0], -m_reg[0], -m_reg[0]}; s[kb][1] = (f32x4){-m_reg[1], -m_reg[1], -m_reg[1], -m_reg[1]}; }
        { const lds_cptr kp = kp0 + kcur; bf16x8 kf[4];
#pragma unroll
          for (int kb = 0; kb < 4; ++kb) kf[kb] = kfr(kp + kb * 16 * KROWB);
          SBAR();
#pragma unroll
          for (int ks = 0; ks < 6; ++ks)
#pragma unroll
              for (int kb = 0; kb < 4; ++kb) { MM16(s[kb][0], kf[kb], qf[0][ks]); MM16(s[kb][1], kf[kb], qf[1][ks]);
                  if (ks < 5) kf[kb] = kfr(kp + kb * 16 * KROWB + (ks + 1) * 64);
                  SBAR(); } }
        if (64 * t + 63 > qlo) {
            const float NEG = -__builtin_inff();
#pragma unroll
            for (int kb = 0; kb < 4; ++kb)
#pragma unroll
                for (int qb = 0; qb < 2; ++qb)
#pragma unroll
                    for (int r = 0; r < 4; ++r) if (64 * t + 16 * kb + 4 * g + r > qlo + 16 * qb + c) s[kb][qb][r] = NEG;
        }
        float pm[2];
#pragma unroll
        for (int qb = 0; qb < 2; ++qb) { float a = fmaxf(fmaxf(s[0][qb][0], s[0][qb][1]), s[0][qb][2]), b = fmaxf(fmaxf(s[0][qb][3], s[1][qb][0]), s[1][qb][1]);
            a = fmaxf(fmaxf(a, s[1][qb][2]), s[1][qb][3]); b = fmaxf(fmaxf(b, s[2][qb][0]), s[2][qb][1]); a = fmaxf(fmaxf(a, s[2][qb][2]), s[2][qb][3]);
            b = fmaxf(fmaxf(b, s[3][qb][0]), s[3][qb][1]); a = fmaxf(fmaxf(a, s[3][qb][2]), s[3][qb][3]); pm[qb] = xmax16(fmaxf(a, b)); }
        if (__builtin_expect(t == 0 || !__all(fmaxf(pm[0], pm[1]) <= THR2), 0)) {
#pragma unroll
            for (int qb = 0; qb < 2; ++qb) { const float d = (t == 0) ? pm[qb] : fmaxf(pm[qb], 0.f); const float al = __builtin_amdgcn_exp2f(-d); m_reg[qb] += d; l_reg[qb] *= al;
#pragma unroll
                for (int kb = 0; kb < 4; ++kb) s[kb][qb] -= d;
#pragma unroll
                for (int db = 0; db < 8; ++db) o[db][qb] *= al; }
        }
#pragma unroll
        for (int qb = 0; qb < 2; ++qb) {
#pragma unroll
            for (int kb = 0; kb < 4; ++kb)
#pragma unroll
                for (int r = 0; r < 4; ++r) s[kb][qb][r] = __builtin_amdgcn_exp2f(s[kb][qb][r]);
            f32x2 s2 = {s[0][qb][0], s[0][qb][1]}; s2 += (f32x2){s[0][qb][2], s[0][qb][3]};
#pragma unroll
            for (int kb = 1; kb < 4; ++kb) { s2 += (f32x2){s[kb][qb][0], s[kb][qb][1]}; s2 += (f32x2){s[kb][qb][2], s[kb][qb][3]}; }
            l_reg[qb] += s2[0] + s2[1];
#pragma unroll
            for (int sp = 0; sp < 2; ++sp) { u32x4 w; w.x = cvt_pk_bf16(s[2 * sp][qb][0], s[2 * sp][qb][1]); w.y = cvt_pk_bf16(s[2 * sp][qb][2], s[2 * sp][qb][3]);
                w.z = cvt_pk_bf16(s[2 * sp + 1][qb][0], s[2 * sp + 1][qb][1]); w.w = cvt_pk_bf16(s[2 * sp + 1][qb][2], s[2 * sp + 1][qb][3]); pf[sp][qb] = *reinterpret_cast<bf16x8*>(&w); }
        }
        }
    };
    auto step_pv = [&](int t) __attribute__((always_inline)) {
        if (act)
        { const lds_cptr vp = vp0 + vcur; s16x4 vl[3], vh[3];
#pragma unroll
          for (int db = 0; db < 3; ++db) { vl[db] = vtr(vp + 32 * db); vh[db] = vtr(vp + 16 * VROWB + 32 * db); }
          SBAR();
#pragma unroll
          for (int i = 0; i < 16; ++i) { const int sp = i >> 3, db = i & 7, sl = i % 3;
              const bf16x8 vf = (bf16x8){vl[sl][0], vl[sl][1], vl[sl][2], vl[sl][3], vh[sl][0], vh[sl][1], vh[sl][2], vh[sl][3]};
              MM16(o[db][0], vf, pf[sp][0]); MM16(o[db][1], vf, pf[sp][1]);
              if (i + 3 < 16) { const int sp2 = (i + 3) >> 3, db2 = (i + 3) & 7; vl[sl] = vtr(vp + (32 * sp2) * VROWB + 32 * db2); vh[sl] = vtr(vp + (32 * sp2 + 16) * VROWB + 32 * db2); }
              SBAR(); } }
    };
    for (int t = 0; t < NT; t += 2) {
        ASTEP(t, sa0, sa1, sa2);
        ASTEP(t + 1, sb0, sb1, sb2);
    }
#undef ASTEP
#undef KLOAD
#undef VLOAD
#undef KWRITE
#undef VWRITE
#undef KOFF
#pragma unroll
    for (int qb = 0; qb < 2; ++qb) { const float rl = __builtin_amdgcn_rcpf(xsum16(l_reg[qb])); bf16_t* Ow = Oh + (size_t)(qlo + 16 * qb + c) * OP + 8 * (g >> 1) + 16 * (g & 1);
#pragma unroll
        for (int j = 0; j < 4; ++j) { const f32x4 ve = o[2 * j][qb] * rl, vo = o[2 * j + 1][qb] * rl;
            const unsigned ex = cvt_pk_bf16(ve[0], ve[1]), ey = cvt_pk_bf16(ve[2], ve[3]), ox = cvt_pk_bf16(vo[0], vo[1]), oy = cvt_pk_bf16(vo[2], vo[3]);
            auto rx = __builtin_amdgcn_permlane16_swap(ex, ox, false, false); auto ry = __builtin_amdgcn_permlane16_swap(ey, oy, false, false);
            u32x4 w; w.x = rx[0]; w.y = ry[0]; w.z = rx[1]; w.w = ry[1]; *(u32x4*)(Ow + 32 * j) = w; } }
    __syncthreads();
}
#undef SBAR
#undef MM16
}

__device__ __forceinline__ int win_src(int n) {
    if (n < 1024) return 1728 + n;
    if (n < 2048) return 2752 + (n - 1024);
    if (n < 4096) return 3776 + (n - 2048);
    if (n < 6144) return 5824 + (n - 4096);
    if (n < 7168) return 704 + (n - 6144);
    if (n < 8192) return 7872 + (n - 7168);
    if (n < 9216) return 8896 + (n - 8192);
    const int m = n - 9216;
    if (m < 640) return m;
    if (m < 704) { const int p = m - 640; return 640 + ((p & 1) ? 32 + (p >> 1) : (p >> 1)); }
    return -1;
}
__device__ __forceinline__ int wq_src(int n) {
    if (n < 1024) { const int t = n >> 8, bj = (n >> 7) & 1, i = n & 127; return (2 * t + bj) * 192 + i; }
    const int m = n - 1024, t4 = m >> 8, bj = (m >> 7) & 1, hh = (m >> 5) & 3, i = m & 31; return (t4 * 4 + hh) * 192 + 128 + bj * 32 + i;
}
template <int WHICH, bool SC>
__device__ __forceinline__ void transpose_item(const float* W, int K, int Nsrc, int nkb, const float* kscale, bf16_t* WT, LAS float* scr, int item, int lane) {
    const int nb = item / nkb, kb = item - nb * nkb, k0 = 64 * kb, n0 = 64 * nb;
    float tv[2][32];
#pragma unroll
    for (int s = 0; s < 2; ++s) { const int n = n0 + 32 * s + (lane & 31); const int src = WHICH == 0 ? win_src(n) : WHICH == 1 ? wq_src(n) : n;
#pragma unroll
        for (int i = 0; i < 32; ++i) { const int kk = 2 * i + (lane >> 5); float v = 0.f; if (src >= 0) v = W[(size_t)(k0 + kk) * Nsrc + src]; tv[s][i] = v; } }
    f32x4 ks0 = {1.f, 1.f, 1.f, 1.f}, ks1 = ks0; if (SC) { ks0 = *(const f32x4*)(kscale + k0 + 8 * (lane & 7)); ks1 = *(const f32x4*)(kscale + k0 + 8 * (lane & 7) + 4); }
#pragma unroll
    for (int s = 0; s < 2; ++s) {
#pragma unroll
        for (int i = 0; i < 32; ++i) { const int kk = 2 * i + (lane >> 5); scr[kk * 33 + (lane & 31)] = tv[s][i]; }
        LDS_WAIT(); asm volatile("" ::: "memory");
        const int c = lane & 7;
#pragma unroll
        for (int j = 0; j < 4; ++j) { const int nn = (lane >> 3) + 8 * j; const LAS float* sp = scr + (8 * c) * 33 + nn;
            u32x4 o; if (SC) { o.x = pk2(sp[0 * 33] * ks0[0], sp[1 * 33] * ks0[1]); o.y = pk2(sp[2 * 33] * ks0[2], sp[3 * 33] * ks0[3]); o.z = pk2(sp[4 * 33] * ks1[0], sp[5 * 33] * ks1[1]); o.w = pk2(sp[6 * 33] * ks1[2], sp[7 * 33] * ks1[3]); }
            else { o.x = pk2(sp[0 * 33], sp[1 * 33]); o.y = pk2(sp[2 * 33], sp[3 * 33]); o.z = pk2(sp[4 * 33], sp[5 * 33]); o.w = pk2(sp[6 * 33], sp[7 * 33]); }
            *(u32x4*)(WT + (size_t)(n0 + 32 * s + nn) * K + k0 + 8 * c) = o; }
        LDS_WAIT(); asm volatile("" ::: "memory"); }
}
__device__ __forceinline__ void phase_prep(const Ctx& X, LAS unsigned char* lds) {
    for (int it = blockIdx.x; it < 8 * 12; it += X.G) {
        const int ks8 = it / 12, jb = it - ks8 * 12, col = jb * 256 + (X.tid & 255), slice = ks8 * 2 + (X.tid >> 8);
        float a = 0.f; const float* const cp = INF(I_C); const float* const wa = INF(I_WADA);
#pragma unroll 1
        for (int k0 = slice * 64; k0 < slice * 64 + 64; k0 += 32) { float w[32];
#pragma unroll
            for (int k = 0; k < 32; ++k) w[k] = wa[(size_t)(k0 + k) * 3072 + col];
#pragma unroll
            for (int k = 0; k < 32; ++k) a += siluf_(cp[k0 + k]) * w[k]; }
        ((float*)(X.ws + WS_MODP))[slice * 3072 + col] = a;
    }
    if (blockIdx.x < 8 * 12) {
        VM_WAIT(); __syncthreads();
        if (X.tid == 0) { __builtin_amdgcn_fence(__ATOMIC_RELEASE, "agent"); asm volatile("s_waitcnt vmcnt(0)" ::: "memory");
            __hip_atomic_fetch_add((unsigned*)(X.ws + WS_CTL) + CW_GEMV, 1u, __ATOMIC_RELAXED, __HIP_MEMORY_SCOPE_AGENT); }
    }
    LAS float* scr = (LAS float*)(lds + X.wave * 16384);
    const int gw = X.vcu * NWAVES + X.wave, NGW = X.G * NWAVES;
    constexpr int I_IN = (NWIN / 64) * 16, I_Q = (1536 / 64) * 6, I_KV = (2048 / 64) * 4, I_PM = 16 * 16, I_PR = 16 * 32, I_O = 16 * 16;
    constexpr int NITEMS = I_IN + I_Q + I_KV + I_PM + I_PR + I_O;
    for (int it = gw; it < NITEMS; it += NGW) {
        int r = it;
        if (r < I_IN) { transpose_item<0, false>(INF(I_WIN), 1024, 9920, 16, nullptr, (bf16_t*)(X.ws + WS_WIN), scr, r, X.lane); continue; } r -= I_IN;
        if (r < I_Q) { transpose_item<1, true>(INF(I_WQUP), 384, 1536, 6, INF(I_GQ), (bf16_t*)(X.ws + WS_WQ), scr, r, X.lane); continue; } r -= I_Q;
        if (r < I_KV) { transpose_item<2, true>(INF(I_WKVUP), 256, 2048, 4, INF(I_GKV), (bf16_t*)(X.ws + WS_WKV), scr, r, X.lane); continue; } r -= I_KV;
        if (r < I_PM) { transpose_item<2, false>(INF(I_WPM), 1024, 1024, 16, nullptr, (bf16_t*)(X.ws + WS_WPM), scr, r, X.lane); continue; } r -= I_PM;
        if (r < I_PR) { transpose_item<2, false>(INF(I_WPR), 2048, 1024, 32, nullptr, (bf16_t*)(X.ws + WS_WPR), scr, r, X.lane); continue; } r -= I_PR;
        transpose_item<2, false>(INF(I_WOUT), 1024, 1024, 16, nullptr, (bf16_t*)(X.ws + WS_WO), scr, r, X.lane);
    }
}
__device__ __forceinline__ void phase_h(const Ctx& X, LAS unsigned char* lds) {
    LAS float* modl = (LAS float*)lds;
    if (X.tid == 0) { unsigned sp = 0; const unsigned* cg = (const unsigned*)(X.ws + WS_CTL) + CW_GEMV;
        while (__hip_atomic_load(cg, __ATOMIC_RELAXED, __HIP_MEMORY_SCOPE_AGENT) < 96u) { __builtin_amdgcn_s_sleep(8); if (++sp > (1u << 22)) break; }
        __builtin_amdgcn_fence(__ATOMIC_ACQUIRE, "agent"); asm volatile("s_waitcnt vmcnt(0)" ::: "memory"); }
    __syncthreads();
    const float* const badap = INF(I_BADA); const float* const gprep = INF(I_GPRE); const float* const xp = INF(I_X);
    { float pv[4][16], bv[4];
#pragma unroll
      for (int q = 0; q < 4; ++q) { const float* mp = (const float*)(X.ws + WS_MODP) + X.tid + 512 * q; bv[q] = badap[X.tid + 512 * q];
#pragma unroll
          for (int s = 0; s < 16; ++s) pv[q][s] = mp[s * 3072]; }
#pragma unroll
      for (int q = 0; q < 4; ++q) { const int j = X.tid + 512 * q; float a = bv[q];
#pragma unroll
          for (int s = 0; s < 16; ++s) a += pv[q][s];
          modl[j] = a; if (blockIdx.x == 0) ((float*)(X.ws + WS_MOD))[j] = a; } }
    if (blockIdx.x == 0) {
        float pv[2][16], bv[2];
#pragma unroll
        for (int q = 0; q < 2; ++q) { const float* mp = (const float*)(X.ws + WS_MODP) + 2048 + X.tid + 512 * q; bv[q] = badap[2048 + X.tid + 512 * q];
#pragma unroll
            for (int s = 0; s < 16; ++s) pv[q][s] = mp[s * 3072]; }
#pragma unroll
        for (int q = 0; q < 2; ++q) { float a = bv[q];
#pragma unroll
            for (int s = 0; s < 16; ++s) a += pv[q][s];
            ((float*)(X.ws + WS_MOD))[2048 + X.tid + 512 * q] = a; } }
    __syncthreads();
    f32x4 ca[4], cb[4];
#pragma unroll
    for (int j = 0; j < 4; ++j) { const int col = 256 * j + 4 * X.lane;
#pragma unroll
        for (int q = 0; q < 4; ++q) { ca[j][q] = gprep[col + q] * (1.0f + modl[1024 + col + q]); cb[j][q] = modl[col + q]; } }
    const int gw = X.vcu * NWAVES + X.wave, NGW = X.G * NWAVES;
    {
        f32x4 v[8][4];
#pragma unroll
        for (int r = 0; r < 8; ++r) { const f32x4* xr = (const f32x4*)(xp + (size_t)(gw + r * NGW) * DM) + X.lane;
#pragma unroll
            for (int j = 0; j < 4; ++j) v[r][j] = xr[64 * j]; }
#pragma unroll
        for (int r = 0; r < 8; ++r) { float s2 = 0.f;
#pragma unroll
            for (int j = 0; j < 4; ++j) s2 += (v[r][j][0] * v[r][j][0] + v[r][j][1] * v[r][j][1]) + (v[r][j][2] * v[r][j][2] + v[r][j][3] * v[r][j][3]);
            const float rstd = __builtin_amdgcn_rsqf(wave_sum(s2) * (1.0f / DM) + EPS);
            u32x2* o8 = (u32x2*)((bf16_t*)(X.ws + WS_H) + (size_t)(gw + r * NGW) * DM) + X.lane;
#pragma unroll
            for (int j = 0; j < 4; ++j) { const f32x4 y = v[r][j] * rstd * ca[j] + cb[j]; u32x2 w; w.x = pk2(y[0], y[1]); w.y = pk2(y[2], y[3]); o8[64 * j] = w; } }
    }
    __syncthreads();
}
__device__ __forceinline__ void phase_scan(const Ctx& X) {
    const int gt = blockIdx.x * NTHR + X.tid;
    const int h = gt >> 15, e = (gt >> 7) & 255, d2 = gt & 127; const float g = fast_exp2(256.0f * l2gamma(h));
    unsigned* p = (unsigned*)((bf16_t*)(X.ws + WS_VRH) + ((size_t)(h * 256 + e) * 64) * 512 + 256 + 2 * d2);
    float r0 = 0.f, r1 = 0.f;
#pragma unroll 1
    for (int c0 = 0; c0 < 64; c0 += 32) {
        unsigned u[32];
#pragma unroll
        for (int c = 0; c < 32; ++c) u[c] = p[(size_t)(c0 + c) * 256];
#pragma unroll
        for (int c = 0; c < 32; ++c) { p[(size_t)(c0 + c) * 256] = cvt_pk_bf16(r0, r1); r0 = g * r0 + bflo(u[c]); r1 = g * r1 + bfhi(u[c]); }
    }
}
__device__ __forceinline__ void phase_norm(const Ctx& X) {
    const int gw = X.vcu * NWAVES + X.wave, NGW = X.G * NWAVES; const float* fsq = (const float*)(X.ws + WS_FSQ);
    f32x4 gf[4];
#pragma unroll
    for (int j = 0; j < 4; ++j) gf[j] = *((const f32x4*)INF(I_GFINAL) + 64 * j + X.lane);
    for (int m0 = gw; m0 < SEQ; m0 += 4 * NGW) {
        f32x4 v[4][4], q[4][4];
#pragma unroll
        for (int r = 0; r < 4; ++r) { const int m = m0 + r * NGW; const f32x4* sp = (const f32x4*)(fsq + (size_t)m * 16); const f32x4* xr = (const f32x4*)(X.out + (size_t)m * DM) + X.lane;
#pragma unroll
            for (int j = 0; j < 4; ++j) { q[r][j] = sp[j]; v[r][j] = xr[64 * j]; } }
#pragma unroll
        for (int r = 0; r < 4; ++r) { const int m = m0 + r * NGW; float ss = 0.f;
#pragma unroll
            for (int j = 0; j < 4; ++j) ss += (q[r][j][0] + q[r][j][1]) + (q[r][j][2] + q[r][j][3]);
            const float rstd = 1.0f / sqrtf(ss * (1.0f / DM) + EPS);
            f32x4* xr = (f32x4*)(X.out + (size_t)m * DM) + X.lane;
#pragma unroll
            for (int j = 0; j < 4; ++j) xr[64 * j] = v[r][j] * rstd * gf[j]; }
    }
}

enum Op { OP_PREP = 0, OP_H, OP_GEMM, OP_SCAN, OP_ATTN, OP_NORM };
enum Sync { SY_NONE = 0, SY_LOCAL, SY_GRID, SY_PANEL, SY_AFLAG, SY_WAR };
struct Step { int op, sync; GCall g; };
__device__ const Step STEPS[] = {
    {OP_PREP, SY_NONE, {0, 0, 0, 0, 0, 0, 0}},
    {OP_H,    SY_GRID, {0, 0, 0, 0, 0, 0, 0}},
    {OP_GEMM, SY_NONE,  {K_QK,    8, 1024, 1024, 1024, 0, 0}},
    {OP_GEMM, SY_NONE,  {K_TRANS, 4, 1024, 1024, 1024, 0, 0}},
    {OP_GEMM, SY_LOCAL, {K_LOW,   3, 1024, 1024, 1024, 0, 0}},
    {OP_GEMM, SY_NONE,  {K_S,     4, 256,  512,  256,  0, 0}},
    {OP_GEMM, SY_GRID,  {K_U,     4, 256, 32768, SEQ,  0, 0}},
    {OP_SCAN, SY_GRID,  {0, 0, 0, 0, 0, 0, 0}},
    {OP_GEMM, SY_NONE,  {K_MAIN,  4, 512,  512, 32768, 0, 0}},
    {OP_GEMM, SY_LOCAL, {K_TRANS, 4, 1024, 1024, 1024, 1, 0}},
    {OP_GEMM, SY_GRID,  {K_U,     4, 256, 32768, SEQ,  1, 0}},
    {OP_SCAN, SY_GRID,  {0, 0, 0, 0, 0, 0, 0}},
    {OP_GEMM, SY_NONE,  {K_MAIN,  4, 512,  512, 32768, 1, 0}},
    {OP_GEMM, SY_WAR,   {K_GRET,  8, 1024, 1024, 1024, 0, 0}},
    {OP_GEMM, SY_NONE,  {K_QUP,   6, 384,  384,  384,  0, 0}},
    {OP_GEMM, SY_GRID,  {K_KVUP,  8, 256,  256,  256,  0, 0}},
    {OP_ATTN, SY_AFLAG, {0, 0, 0, 0, 0, 0, 0}},
    {OP_GEMM, SY_NONE,  {K_GMLA,  4, 1024, 1024, 1024, 0, 0}},
    {OP_GEMM, SY_PANEL, {K_P0,    4, 1024, 1024, 1024, 0, 1}},
    {OP_GEMM, SY_NONE,  {K_P1,    4, 1024, 1024, 1024, 0, 0}},
    {OP_GEMM, SY_NONE,  {K_P2,    4, 1024, 1024, 1024, 0, 0}},
    {OP_GEMM, SY_PANEL, {K_P3,    4, 2048, 2048, 2048, 0, 2}},
    {OP_GEMM, SY_NONE,  {K_FINAL, 4, 1024, 1024, 1024, 0, 0}} };
constexpr int NSTEPS = 23;
__device__ __forceinline__ GCall step_call(int si) { return STEPS[si].g; }

constexpr int NPHASES = NSTEPS;
struct Args { const void* in[16]; float* out; unsigned char* ws; int ph_lo, ph_hi; };
__global__ void __launch_bounds__(NTHR, 2) fwd_kernel(Args args) {
    extern __shared__ __attribute__((aligned(16))) unsigned char lds_raw[];
    LAS unsigned char* lds = (LAS unsigned char*)lds_raw;
    Ctx X; X.out = args.out; X.ws = args.ws;
    X.tid = threadIdx.x; X.lane = X.tid & 63; X.wave = __builtin_amdgcn_readfirstlane(X.tid >> 6);
    X.G = gridDim.x; { const int bx = blockIdx.x; X.vcu = (bx % 8) * (X.G / 8) + bx / 8; }
    volatile LAS unsigned* MISC = (volatile LAS unsigned*)(lds + MISC_OFF);
    for (int u = X.tid; u < (LDS_BYTES - LDSCTL_OFF) / 4; u += NTHR) ((LAS unsigned*)(lds + LDSCTL_OFF))[u] = 0u;
    __syncthreads();
    if (X.tid < 16) *(LAS unsigned long long*)(lds + PTR_OFF + 8 * X.tid) = (unsigned long long)args.in[X.tid];
    if (X.tid == 16) *(LAS unsigned long long*)(lds + PTR_OFF + 8 * 16) = (unsigned long long)args.out;
    if (X.tid == 17) *(LAS unsigned long long*)(lds + PTR_OFF + 8 * 17) = (unsigned long long)args.ws;
    __syncthreads();
    gu32* ctl = (gu32*)(X.ws + WS_CTL);
    XcdBarrier bar = xcd_barrier_post((unsigned*)(ctl + CW_BAR), MISC + 8);
    const int lo = args.ph_lo, hi = args.ph_hi;
    const Ctx X_ = X;
    for (int si = lo; si < hi; ++si) {
        Ctx X = X_; asm volatile("" : "+v"(X.tid), "+v"(X.lane), "+s"(X.wave), "+s"(X.vcu)); X.out = (float*)inptr_raw(16); X.ws = (unsigned char*)inptr_raw(17);
        const int op = STEPS[si].op, sync = STEPS[si].sync;
        if (op == OP_PREP) phase_prep(X, lds);
        else if (op == OP_H) phase_h(X, lds);
        else if (op == OP_SCAN) phase_scan(X);
        else if (op == OP_ATTN) {
            const int head = X.vcu >> 5, l = X.vcu & 31;
            const bf16_t* Qh = (const bf16_t*)(X.ws + WS_Q) + head * 192; const bf16_t* Kh = (const bf16_t*)(X.ws + WS_K) + head * 192; const bf16_t* Vh = (const bf16_t*)(X.ws + WS_V) + head * 128;
            bf16_t* Oh = (bf16_t*)(X.ws + WS_O) + head * 128;
#pragma unroll 1
            for (int pass = 0; pass < 2; ++pass) att16::attn_unit(Qh, Kh, Vh, Oh, 256 * (pass ? 63 - l : l), (char*)lds_raw, X.tid);
        }
        else if (op == OP_NORM) phase_norm(X);
        int sync_ = sync;
        if (op == OP_GEMM) { int ns = 1; while (si + ns < hi && STEPS[si + ns - 1].sync == SY_NONE && STEPS[si + ns].op == OP_GEMM) ++ns;
            gemm_stream(lds, si, ns, X); si += ns - 1; sync_ = STEPS[si].sync; }
        if (si + 1 < hi) {
            if (sync_ == SY_GRID) { xcd_barrier(bar);
            }
            else if (sync_ == SY_PANEL) {
                VM_WAIT(); __syncthreads();
                if (X.tid == 0) { unsigned* cp = (unsigned*)(X.ws + WS_CTL) + CW_PANEL + 64 * (8 * (X.vcu >> 5) + (X.vcu & 7));
                    __builtin_amdgcn_fence(__ATOMIC_RELEASE, "agent"); asm volatile("s_waitcnt vmcnt(0)" ::: "memory");
                    __hip_atomic_fetch_add(cp, 1u, __ATOMIC_RELAXED, __HIP_MEMORY_SCOPE_AGENT);
                    const unsigned panel_need = 4u * (unsigned)STEPS[si].g.nk;
                    unsigned sp = 0; while (__hip_atomic_load(cp, __ATOMIC_RELAXED, __HIP_MEMORY_SCOPE_AGENT) < panel_need) { __builtin_amdgcn_s_sleep(4); if (++sp > (1u << 22)) break; }
                    __builtin_amdgcn_fence(__ATOMIC_ACQUIRE, "agent"); asm volatile("s_waitcnt vmcnt(0)" ::: "memory"); }
                __syncthreads(); }
            else if (sync_ == SY_AFLAG) {
                VM_WAIT(); __syncthreads();
                if (X.tid == 0) { unsigned* fl = (unsigned*)(X.ws + WS_CTL) + CW_AFLAG; const int l_ = X.vcu & 31;
                    __builtin_amdgcn_fence(__ATOMIC_RELEASE, "agent"); asm volatile("s_waitcnt vmcnt(0)" ::: "memory");
                    __hip_atomic_fetch_add((unsigned*)(X.ws + WS_CTL) + CW_ADONE, 1u, __ATOMIC_RELAXED, __HIP_MEMORY_SCOPE_AGENT);
                    __hip_atomic_store(fl + (X.vcu >> 5) * 64 + l_, 1u, __ATOMIC_RELAXED, __HIP_MEMORY_SCOPE_AGENT); __hip_atomic_store(fl + (X.vcu >> 5) * 64 + 63 - l_, 1u, __ATOMIC_RELAXED, __HIP_MEMORY_SCOPE_AGENT);
                    const int t_ = 8 * (X.vcu >> 5) + (X.vcu & 7), o_ = (X.vcu & 31) >> 3; const unsigned* f0 = fl + (2 * o_) * 64 + t_;
                    unsigned sp = 0; while ((__hip_atomic_load(f0, __ATOMIC_RELAXED, __HIP_MEMORY_SCOPE_AGENT) & __hip_atomic_load(f0 + 64, __ATOMIC_RELAXED, __HIP_MEMORY_SCOPE_AGENT)) == 0u) { __builtin_amdgcn_s_sleep(4); if (++sp > (1u << 22)) break; }
                    __builtin_amdgcn_fence(__ATOMIC_ACQUIRE, "agent"); asm volatile("s_waitcnt vmcnt(0)" ::: "memory"); }
                __syncthreads(); }
            else if (sync_ == SY_WAR) {
                VM_WAIT(); __syncthreads();
                if (X.tid == 0) { const unsigned* cw = (const unsigned*)(X.ws + WS_CTL) + CW_WAR;
                    unsigned sp = 0; while (__hip_atomic_load(cw, __ATOMIC_RELAXED, __HIP_MEMORY_SCOPE_AGENT) < (unsigned)X.G) { __builtin_amdgcn_s_sleep(4); if (++sp > (1u << 22)) break; }
                    __builtin_amdgcn_fence(__ATOMIC_ACQUIRE, "agent"); asm volatile("s_waitcnt vmcnt(0)" ::: "memory"); }
                __syncthreads(); }
            else if (sync_ == SY_LOCAL) { VM_WAIT(); __syncthreads(); if (X.tid == 0) { __builtin_amdgcn_fence(__ATOMIC_ACQUIRE, "agent"); } VM_WAIT(); __syncthreads(); }
        }
    }
}


extern "C" void kernel_launch(void* const* d_in, const int* in_sizes, int n_in, void* d_out, int out_size, void* d_ws, size_t ws_size, hipStream_t stream) {
    static int grid = 0;
    if (grid == 0) {
        if (n_in != 16 || out_size != SEQ * DM || ws_size < WS_END) { fprintf(stderr, "kernel_launch: unexpected shapes (n_in %d out %d ws %zu)\n", n_in, out_size, ws_size); grid = -1; return; }
        int dev = 0, cus = 0;
        if (hipGetDevice(&dev) != hipSuccess || hipDeviceGetAttribute(&cus, hipDeviceAttributeMultiprocessorCount, dev) != hipSuccess) { grid = -1; return; }
        if (hipFuncSetAttribute((const void*)fwd_kernel, hipFuncAttributeMaxDynamicSharedMemorySize, LDS_BYTES) != hipSuccess) { fprintf(stderr, "kernel_launch: hipFuncSetAttribute failed\n"); grid = -1; return; }
        (void)hipGetLastError();
        grid = cus;
        if (grid != 256) { fprintf(stderr, "kernel_launch: built for 256 CUs, found %d\n", cus); grid = -1; return; }
    }
    if (grid < 0) return;
    (void)in_sizes;
    if (hipMemsetAsync((char*)d_ws + WS_CTL, 0, CTL_ZERO_BYTES, stream) != hipSuccess) return;
    Args a{};
    for (int i = 0; i < 16; ++i) a.in[i] = d_in[i];
    a.out = (float*)d_out; a.ws = (unsigned char*)d_ws; a.ph_lo = 0; a.ph_hi = NPHASES;
    hipLaunchKernelGGL(fwd_kernel, dim3(grid), dim3(NTHR), LDS_BYTES, stream, a);
}
```

```cpp
#include <hip/hip_runtime.h>
#include <cstdio>
#include <cstdint>

#define GAS __attribute__((address_space(1)))
#define LAS __attribute__((address_space(3)))
typedef unsigned short bf16_t;
typedef short bf16x8 __attribute__((ext_vector_type(8)));
typedef short s16x4 __attribute__((ext_vector_type(4)));
typedef float f32x4 __attribute__((ext_vector_type(4)));
typedef float f32x2 __attribute__((ext_vector_type(2)));
typedef float f32x16 __attribute__((ext_vector_type(16)));
typedef unsigned u32x4 __attribute__((ext_vector_type(4)));
typedef unsigned u32x2 __attribute__((ext_vector_type(2)));
typedef GAS unsigned gu32;

constexpr int SEQ = 16384, DM = 1024;
constexpr int NWAVES = 8, NTHR = 512;
constexpr float EPS = 1e-6f;
constexpr int NWIN = 9984;
constexpr int WT_QRET = 0, WT_KRET = 4, WT_VRET = 8, WT_GRET = 16, WT_GMLA = 24, WT_MMLA = 28, WT_MRET = 32, WT_LOW = 36;

constexpr size_t MiB = 1u << 20;
constexpr size_t WS_CTL = 0, CTL_ZERO_BYTES = 64 * 1024;
constexpr size_t WS_MODP = 128 * 1024;
constexpr size_t WS_MOD = 512 * 1024;
constexpr size_t WS_FSQ = 1 * MiB;
constexpr size_t WS_PSQ = 2 * MiB;
constexpr size_t WS_STAT = 4 * MiB;
constexpr size_t WS_WIN = 8 * MiB;
constexpr size_t WS_WQ = 28 * MiB;
constexpr size_t WS_WKV = 30 * MiB;
constexpr size_t WS_WPM = 31 * MiB;
constexpr size_t WS_WPR = 33 * MiB;
constexpr size_t WS_WO = 37 * MiB;
constexpr size_t WS_H = 40 * MiB;
constexpr size_t WS_X = 72 * MiB;
constexpr size_t WS_AQ = WS_X;
constexpr size_t WS_VRH = WS_X + 64 * MiB;
constexpr size_t WS_KZT = WS_X + 128 * MiB;
constexpr size_t WS_CQ = WS_X + 160 * MiB;
constexpr size_t WS_CKV = WS_X + 172 * MiB;
constexpr size_t WS_KROPE = WS_X + 180 * MiB;
constexpr size_t WS_Q = WS_X + 24 * MiB;
constexpr size_t WS_K = WS_X + 72 * MiB;
constexpr size_t WS_V = WS_X + 120 * MiB;
constexpr size_t WS_O = WS_X + 152 * MiB;
constexpr size_t WS_SCRA = WS_X;
constexpr size_t WS_SCRB = WS_X + 32 * MiB;
constexpr size_t WS_SCRA2 = WS_X + 64 * MiB;
constexpr size_t WS_MERGED = WS_X + 96 * MiB;
constexpr size_t WS_END = 256 * MiB;

constexpr int CW_BAR = 4096;
constexpr int CW_CNT = 8192;
constexpr int CW_PANEL = 12288;
constexpr int CW_ADONE = 2816;
constexpr int CW_WAR = 2560;
constexpr int CW_GEMV = 2048;
constexpr int CW_AFLAG = 3072;

constexpr int RING_BYTES = 131072;
constexpr int LDSCTL_OFF = RING_BYTES, MISC_OFF = LDSCTL_OFF + 320;
constexpr int LDS_BYTES = 147456;

#define RLX_AGENT __ATOMIC_RELAXED, __HIP_MEMORY_SCOPE_AGENT
#define LDS_WAIT() asm volatile("s_waitcnt lgkmcnt(0)" ::: "memory")
#define VM_WAIT() asm volatile("s_waitcnt vmcnt(0)" ::: "memory")
__device__ __forceinline__ unsigned f2bf(float f) { unsigned u = __builtin_bit_cast(unsigned, f); return (u + 0x7fffu + ((u >> 16) & 1u)) >> 16; }
__device__ __forceinline__ unsigned pk2(float lo, float hi) { return f2bf(lo) | (f2bf(hi) << 16); }
__device__ __forceinline__ float bf2f(unsigned short b) { return __builtin_bit_cast(float, ((unsigned)b) << 16); }
__device__ __forceinline__ float bflo(unsigned w) { return __builtin_bit_cast(float, w << 16); }
__device__ __forceinline__ float bfhi(unsigned w) { return __builtin_bit_cast(float, w & 0xffff0000u); }
typedef __bf16 bf16x2_t __attribute__((ext_vector_type(2)));
__device__ __forceinline__ unsigned cvt_pk_bf16(float lo, float hi) { f32x2 v = {lo, hi}; bf16x2_t b = __builtin_convertvector(v, bf16x2_t); return __builtin_bit_cast(unsigned, b); }
__device__ __forceinline__ float fast_exp2(float x) { return __builtin_amdgcn_exp2f(x); }
__device__ __forceinline__ float fast_rcp(float x) { return __builtin_amdgcn_rcpf(x); }
__device__ __forceinline__ float sigmoidf_(float x) { return fast_rcp(1.0f + fast_exp2(-1.4426950408889634f * x)); }
__device__ __forceinline__ float siluf_(float x) { return x * sigmoidf_(x); }
__device__ __forceinline__ void sincos_ang(float ang, float& s, float& c) {
    const float hi = 0.15915493667125702f, lo = 6.420638326565253e-09f;
    const float p = ang * hi; float e = __builtin_fmaf(ang, hi, -p); e = __builtin_fmaf(ang, lo, e);
    const float f = (p - __builtin_rintf(p)) + e;
    s = __builtin_amdgcn_sinf(f); c = __builtin_amdgcn_cosf(f);
}
__device__ __forceinline__ float wave_sum(float v) {
#pragma unroll
    for (int o = 1; o < 64; o <<= 1) v += __shfl_xor(v, o);
    return v;
}
__device__ const float INVF[128] = { 1.000000000e+00f, 9.305720329e-01f, 8.659643531e-01f, 8.058421612e-01f, 7.498942018e-01f, 6.978305578e-01f, 6.493816376e-01f, 6.042963862e-01f, 5.623413324e-01f, 5.232990980e-01f, 4.869675338e-01f, 4.531583786e-01f, 4.216965139e-01f, 3.924189806e-01f, 3.651741147e-01f, 3.398208320e-01f, 3.162277639e-01f, 2.942727208e-01f, 2.738419771e-01f, 2.548296750e-01f, 2.371373773e-01f, 2.206734121e-01f, 2.053525001e-01f, 1.910952926e-01f, 1.778279394e-01f, 1.654817164e-01f, 1.539926529e-01f, 1.433012635e-01f, 1.333521456e-01f, 1.240937784e-01f, 1.154781953e-01f, 1.074607819e-01f, 1.000000015e-01f, 9.305720776e-02f, 8.659642935e-02f, 8.058422059e-02f, 7.498942316e-02f, 6.978306174e-02f, 6.493816525e-02f, 6.042964011e-02f, 5.623413250e-02f, 5.232991278e-02f, 4.869675264e-02f, 4.531583562e-02f, 4.216964915e-02f, 3.924189880e-02f, 3.651741147e-02f, 3.398208320e-02f, 3.162277490e-02f, 2.942727134e-02f, 2.738419548e-02f, 2.548296750e-02f, 2.371373773e-02f, 2.206734009e-02f, 2.053525113e-02f, 1.910953037e-02f, 1.778279431e-02f, 1.654817164e-02f, 1.539926510e-02f, 1.433012541e-02f, 1.333521400e-02f, 1.240937784e-02f, 1.154781971e-02f, 1.074607857e-02f, 9.999999776e-03f, 9.305720218e-03f, 8.659643121e-03f, 8.058422245e-03f, 7.498942316e-03f, 6.978305988e-03f, 6.493816152e-03f, 6.042963825e-03f, 5.623413250e-03f, 5.232991185e-03f, 4.869675264e-03f, 4.531583749e-03f, 4.216964822e-03f, 3.924189601e-03f, 3.651741194e-03f, 3.398208413e-03f, 3.162277630e-03f, 2.942727180e-03f, 2.738419687e-03f, 2.548296703e-03f, 2.371373819e-03f, 2.206734149e-03f, 2.053525066e-03f, 1.910952968e-03f, 1.778279431e-03f, 1.654817141e-03f, 1.539926510e-03f, 1.433012541e-03f, 1.333521446e-03f, 1.240937738e-03f, 1.154782018e-03f, 1.074607833e-03f, 1.000000047e-03f, 9.305720450e-04f, 8.659643354e-04f, 8.058421663e-04f, 7.498941850e-04f, 6.978305755e-04f, 6.493816036e-04f, 6.042963942e-04f, 5.623413017e-04f, 5.232990952e-04f, 4.869675322e-04f, 4.531583691e-04f, 4.216965172e-04f, 3.924189659e-04f, 3.651741135e-04f, 3.398208355e-04f, 3.162277571e-04f, 2.942727297e-04f, 2.738419571e-04f, 2.548296761e-04f, 2.371373703e-04f, 2.206734061e-04f, 2.053525095e-04f, 1.910952997e-04f, 1.778279402e-04f, 1.654817170e-04f, 1.539926598e-04f, 1.433012512e-04f, 1.333521504e-04f, 1.240937709e-04f, 1.154782003e-04f, 1.074607862e-04f };
__device__ __forceinline__ float l2gamma(int h) { return h == 0 ? -0.04580368961312479f : h == 1 ? -0.02272007650008353f : h == 2 ? -0.011315313227834146f : -0.005646563141142063f; }

#define XB_TMO      128
#define XB_XCNT(j)  (256  + 64 * (j))
#define XB_XSUB(j)  (1280 + 64 * (j))
#define XB_XGEN(j)  (2304 + 64 * (j))
#define XB_TOP      3328
#define XB_TOPGEN   3392
#define XCD_BAR_WORDS 3456
#define XB_SPIN_CAP (1u << 18)
__device__ __forceinline__ unsigned xb_ld(unsigned* p)              { return __hip_atomic_load(p, __ATOMIC_RELAXED, __HIP_MEMORY_SCOPE_AGENT); }
__device__ __forceinline__ unsigned xb_add(unsigned* p, unsigned v) { return __hip_atomic_fetch_add(p, v, __ATOMIC_RELAXED, __HIP_MEMORY_SCOPE_AGENT); }
__device__ __forceinline__ unsigned xb_xcc_id() { return (unsigned)__builtin_amdgcn_s_getreg((3 << 11) | 20) & 0xFu; }
#define XB_SPIN(cond, bar) do { unsigned _sp = 0; while (cond) { __builtin_amdgcn_s_sleep(1); \
    if ((++_sp & 255u) == 0u) { if (xb_ld(&(bar)[XB_TMO])) break; if (_sp > XB_SPIN_CAP) { atomicAdd(&(bar)[XB_TMO], 1u); break; } } } } while (0)
struct XcdBarrier { unsigned* bar; unsigned x; volatile LAS unsigned* st; };
__device__ __forceinline__ XcdBarrier xcd_barrier_post(unsigned* bar, volatile LAS unsigned* st) {
    XcdBarrier b; b.bar = bar; b.x = xb_xcc_id(); b.st = st;
    if (threadIdx.x == 0) (void)xb_add(&bar[XB_XCNT(b.x)], 1u);
    return b;
}
__device__ __forceinline__ void xcd_barrier_complete(unsigned* bar, unsigned x, unsigned& nloc, unsigned& nx) {
    const unsigned G = gridDim.x * gridDim.y * gridDim.z;
    unsigned sum, cnt, mine, sp = 0u;
    for (;;) {
        sum = 0u; cnt = 0u; mine = 0u;
#pragma unroll
        for (unsigned j = 0; j < 16; ++j) { const unsigned c = xb_ld(&bar[XB_XCNT(j)]); sum += c; cnt += (c > 0u) ? 1u : 0u; mine = (j == x) ? c : mine; }
        if (sum == G) break;
        __builtin_amdgcn_s_sleep(1);
        if ((++sp & 255u) == 0u) { if (xb_ld(&bar[XB_TMO])) break; if (sp > XB_SPIN_CAP) { atomicAdd(&bar[XB_TMO], 1u); break; } }
    }
    nloc = mine > 0u ? mine : 1u; nx = cnt > 0u ? cnt : 1u;
}
__device__ __forceinline__ void xcd_barrier(const XcdBarrier& b) {
    asm volatile("s_waitcnt vmcnt(0)" ::: "memory");
    __syncthreads();
    if (threadIdx.x == 0) {
        unsigned* bar = b.bar;
        __builtin_amdgcn_s_waitcnt(0);
        unsigned nloc = b.st[0], nx = b.st[1];
        if (nloc == 0u) { xcd_barrier_complete(bar, b.x, nloc, nx); b.st[0] = nloc; b.st[1] = nx; }
        const unsigned old = xb_add(&bar[XB_XSUB(b.x)], 1u);
        const unsigned gen = old / nloc;
        if (old + 1u == (gen + 1u) * nloc) {
            __builtin_amdgcn_fence(__ATOMIC_RELEASE, "agent");
            asm volatile("s_waitcnt vmcnt(0)" ::: "memory");
            const unsigned og = xb_add(&bar[XB_TOP], 1u);
            const unsigned tg = og / nx;
            if (og + 1u == (tg + 1u) * nx) xb_add(&bar[XB_TOPGEN], 1u);
            else XB_SPIN(xb_ld(&bar[XB_TOPGEN]) == tg, bar);
            __builtin_amdgcn_fence(__ATOMIC_ACQUIRE, "agent");
            xb_add(&bar[XB_XGEN(b.x)], 1u);
            asm volatile("s_waitcnt vmcnt(0)" ::: "memory");
        } else {
            XB_SPIN(xb_ld(&bar[XB_XGEN(b.x)]) == gen, bar);
            __builtin_amdgcn_fence(__ATOMIC_ACQUIRE, "agent");
            asm volatile("s_waitcnt vmcnt(0)" ::: "memory");
        }
    }
    __syncthreads();
}

struct Ctx {
    float* out; unsigned char* ws;
    int tid, lane, wave, vcu, G;
};
enum InIdx { I_X = 0, I_C, I_POS, I_WADA, I_BADA, I_GPRE, I_WIN, I_GQ, I_WQUP, I_GKV, I_WKVUP, I_GRET, I_WPM, I_WPR, I_WOUT, I_GFINAL };
constexpr int PTR_OFF = LDSCTL_OFF;
__device__ __forceinline__ const void* inptr_raw(int k) {
    const volatile LAS unsigned* p = (const volatile LAS unsigned*)(size_t)(PTR_OFF + 8 * k);
    const unsigned lo = (unsigned)__builtin_amdgcn_readfirstlane((int)p[0]), hi = (unsigned)__builtin_amdgcn_readfirstlane((int)p[1]);
    return (const void*)(const GAS char*)(((unsigned long long)hi << 32) | lo);
}
#define INF(k) ((const float*)inptr_raw(k))
#define INI(k) ((const int*)inptr_raw(k))

enum Kind { K_QK = 0, K_TRANS, K_S, K_U, K_MAIN, K_LOW, K_QUP, K_KVUP, K_GMLA, K_GRET, K_P0, K_P1, K_P2, K_P3, K_FINAL };
struct GCall { int kind, NO, K, lda, ldb, hf, nk; };
struct Unit { int t, o; };
constexpr int BK = 64, HALF = 128, HTB = HALF * BK * 2;
constexpr float QSCALE = 0.07216878364870322f * 1.4426950408889634f;

__host__ __device__ __forceinline__ int lds_byte(int r, int c) { const int st = (r >> 4) * 2 + (c >> 5), rr = r & 15, cc = c & 31, ob = rr * 64 + cc * 2; return st * 1024 + (ob ^ (((ob >> 9) & 1) << 5)); }
__host__ __device__ __forceinline__ void stage_rc(int b, int& R, int& C) { const int st = b / 1024, sb = b % 1024, swz = sb ^ (((sb >> 9) & 1) << 5); R = (st >> 1) * 16 + swz / 64; C = (st & 1) * 32 + (swz % 64) / 2; }
__host__ __device__ __forceinline__ int perm32(int rho) { const int n = rho >> 4, i = rho & 15; return 8 * (i >> 2) + 4 * n + (i & 3); }

__device__ __forceinline__ bool unit_next(const GCall& g, int vcu, int i, Unit& u) {
    const int x = vcu >> 5, l = vcu & 31; u.t = 8 * x + (l & 7);
    if (g.kind == K_GRET) { u.o = 2 * (l >> 3) + i; return i < 2; }
    if (g.kind == K_KVUP) { const int q4 = l >> 3; if (q4 < 2) { u.o = q4; return i < 1; } u.o = q4 + 2 * i; return i < 3; }
    u.o = 4 * i + (l >> 3); return u.o < g.NO;
}
__device__ __forceinline__ void unit_ptrs(const GCall& g, const Ctx& X, const Unit& u, const char*& A, const char*& B) {
    size_t z_ = 0; asm volatile("" : "+s"(z_)); const unsigned char* wsb = X.ws + z_; const float* outb = X.out + z_;
    const bf16_t* a = nullptr; const bf16_t* b = nullptr;
    const bf16_t* Hb = (const bf16_t*)(wsb + WS_H); const bf16_t* Win = (const bf16_t*)(wsb + WS_WIN);
    const size_t t = (size_t)u.t, o = (size_t)u.o;
    switch (g.kind) {
    case K_QK:    a = Hb + t * 256 * 1024; b = Win + o * 256 * 1024; break;
    case K_TRANS: { const size_t rt = (u.o < g.nk) ? (size_t)(WT_KRET + u.o) : (size_t)(WT_VRET + (u.o - g.nk) * 2 + g.hf); a = Win + rt * 256 * 1024; b = Hb + t * 256 * 1024; } break;
    case K_S:     a = (const bf16_t*)(wsb + WS_AQ) + (o * SEQ + t * 256) * 512 + 256; b = (const bf16_t*)outb + (o * SEQ + t * 256) * 256; break;
    case K_U:     a = (const bf16_t*)(wsb + WS_VRH) + ((o * 64 + t) * 256) * 512; b = (const bf16_t*)(wsb + WS_KZT) + ((o * 64 + t) * 256) * 256; break;
    case K_MAIN:  a = (const bf16_t*)(wsb + WS_AQ) + (o * SEQ + t * 256) * 512; b = (const bf16_t*)(wsb + WS_VRH) + ((o * 64 + t) * 256) * 512; break;
    case K_LOW:   a = Hb + t * 256 * 1024; b = Win + (WT_LOW + o) * 256 * 1024; break;
    case K_QUP:   a = (const bf16_t*)(wsb + WS_CQ) + t * 256 * 384; b = (const bf16_t*)(wsb + WS_WQ) + o * 256 * 384; break;
    case K_KVUP:  a = (const bf16_t*)(wsb + WS_CKV) + t * 256 * 256; b = (const bf16_t*)(wsb + WS_WKV) + o * 256 * 256; break;
    case K_GMLA:  a = Hb + t * 256 * 1024; b = Win + (WT_GMLA + o) * 256 * 1024; break;
    case K_GRET:  a = Hb + t * 256 * 1024; b = Win + (WT_GRET + o) * 256 * 1024; break;
    case K_P0:    a = Hb + t * 256 * 1024; b = Win + (WT_MMLA + o) * 256 * 1024; break;
    case K_P1:    a = (const bf16_t*)(wsb + WS_O) + t * 256 * 1024; b = (const bf16_t*)(wsb + WS_WPM) + o * 256 * 1024; break;
    case K_P2:    a = Hb + t * 256 * 1024; b = Win + (WT_MRET + o) * 256 * 1024; break;
    case K_P3:    a = (const bf16_t*)outb + t * 256 * 2048; b = (const bf16_t*)(wsb + WS_WPR) + o * 256 * 2048; break;
    default:      a = (const bf16_t*)(wsb + WS_MERGED) + t * 256 * 1024; b = (const bf16_t*)(wsb + WS_WO) + o * 256 * 1024; break;
    }
    A = (const char*)a; B = (const char*)b;
}

__device__ __forceinline__ u32x4 pack8f(const f32x4 a, const f32x4 b) { u32x4 w; w.x = cvt_pk_bf16(a[0], a[1]); w.y = cvt_pk_bf16(a[2], a[3]); w.z = cvt_pk_bf16(b[0], b[1]); w.w = cvt_pk_bf16(b[2], b[3]); return w; }
__device__ __forceinline__ void unpack8(const u32x4 w, f32x4& a, f32x4& b) { a[0] = bflo(w.x); a[1] = bfhi(w.x); a[2] = bflo(w.y); a[3] = bfhi(w.y); b[0] = bflo(w.z); b[1] = bfhi(w.z); b[2] = bflo(w.w); b[3] = bfhi(w.w); }

struct EpiP { int kind, hf, nk; };
#define PIN8(a) asm volatile("" : "+v"(a[0]), "+v"(a[1]), "+v"(a[2]), "+v"(a[3]), "+v"(a[4]), "+v"(a[5]), "+v"(a[6]), "+v"(a[7]))
__device__ __forceinline__ void epilogue(const GCall& g0, const Ctx& X0, f32x4 (&acc)[2][2][4][2], const Unit& u, int wr, int wc, int fr, int fq) {
    size_t z_ = 0; asm volatile("" : "+s"(z_));
    struct { unsigned char* ws; float* out; } X = {X0.ws + z_, X0.out + z_}; EpiP g = {g0.kind, g0.hf, g0.nk};
    asm volatile("" : "+s"(g.kind), "+s"(g.hf), "+s"(g.nk), "+s"(wr), "+s"(wc), "+v"(fr), "+v"(fq));
    const int t = u.t, o = u.o;
    const int* const posp = INI(I_POS);
    const int cl0 = 32 * wc + 8 * fq;
    const int rl0 = 64 * wr + fr;
    switch (g.kind) {
    case K_QK: {
        const int h = o & 3; const bool isk = o >= 4; const float l2g = l2gamma(h);
        float invf[8];
#pragma unroll
        for (int j = 0; j < 8; ++j) invf[j] = INVF[cl0 + j];
        PIN8(invf);
        bf16_t* dst = isk ? ((bf16_t*)X.out + (size_t)h * SEQ * 256) : ((bf16_t*)(X.ws + WS_AQ) + (size_t)h * SEQ * 512 + 256);
        const int pitch = isk ? 256 : 512;
        int posv[2][4];
#pragma unroll
        for (int ai = 0; ai < 2; ++ai)
#pragma unroll
            for (int m = 0; m < 4; ++m) posv[ai][m] = posp[256 * t + 128 * ai + 16 * m + rl0];
#pragma unroll
        for (int ai = 0; ai < 2; ++ai)
#pragma unroll
            for (int m = 0; m < 4; ++m) {
                const int rl = 128 * ai + 16 * m + rl0, tok = 256 * t + rl;
                const float posf = (float)posv[ai][m];
                const float sc = isk ? 0.0625f * fast_exp2((float)(255 - rl) * l2g) : 1.0f;
                f32x4 o1[2], o2[2];
#pragma unroll
                for (int n = 0; n < 2; ++n)
#pragma unroll
                    for (int j = 0; j < 4; ++j) { float s, c; sincos_ang(posf * invf[4 * n + j], s, c); const float x1 = acc[ai][0][m][n][j], x2 = acc[ai][1][m][n][j];
                        o1[n][j] = (x1 * c - x2 * s) * sc; o2[n][j] = (x2 * c + x1 * s) * sc; }
                bf16_t* p = dst + (size_t)tok * pitch + cl0;
                *(u32x4*)p = pack8f(o1[0], o1[1]); *(u32x4*)(p + 128) = pack8f(o2[0], o2[1]);
                if (isk) {
                    bf16_t* kzt = (bf16_t*)(X.ws + WS_KZT) + ((size_t)(h * 64 + t) * 256) * 256; const bool odd = fr & 1; const int tokp = rl & ~1;
#pragma unroll
                    for (int hb = 0; hb < 2; ++hb)
#pragma unroll
                        for (int n = 0; n < 2; ++n)
#pragma unroll
                            for (int j = 0; j < 4; j += 2) { const float a = hb ? o2[n][j] : o1[n][j], b = hb ? o2[n][j + 1] : o1[n][j + 1];
                                const float recv = __shfl_xor(odd ? a : b, 1);
                                const int d = 128 * hb + cl0 + 4 * n + j + (odd ? 1 : 0);
                                *(unsigned*)(kzt + (size_t)d * 256 + tokp) = odd ? cvt_pk_bf16(recv, b) : cvt_pk_bf16(a, recv); }
                }
            }
    } break;
    case K_TRANS: {
        {
            const int hh = o - g.nk; bf16_t* dst = (bf16_t*)(X.ws + WS_VRH);
#pragma unroll
            for (int ai = 0; ai < 2; ++ai)
#pragma unroll
                for (int m = 0; m < 4; ++m) { const int e = 128 * ai + 16 * m + rl0; bf16_t* p = dst + ((size_t)(hh * 64 + t) * 256 + e) * 512 + cl0;
#pragma unroll
                    for (int bj = 0; bj < 2; ++bj) *(u32x4*)(p + 128 * bj) = pack8f(acc[ai][bj][m][0], acc[ai][bj][m][1]); }
        }
    } break;
    case K_S: {
        const int h = o; const float ginv = fast_exp2(-256.0f * l2gamma(h));
        bf16_t* dst = (bf16_t*)(X.ws + WS_AQ) + ((size_t)h * SEQ + 256 * t) * 512;
#pragma unroll
        for (int ai = 0; ai < 2; ++ai)
#pragma unroll
            for (int m = 0; m < 4; ++m) { const int i = 128 * ai + 16 * m + rl0;
#pragma unroll
                for (int bj = 0; bj < 2; ++bj) { const int j0 = 128 * bj + cl0; f32x4 v[2];
#pragma unroll
                    for (int n = 0; n < 2; ++n)
#pragma unroll
                        for (int j = 0; j < 4; ++j) v[n][j] = (j0 + 4 * n + j <= i) ? acc[ai][bj][m][n][j] * ginv : 0.0f;
                    *(u32x4*)(dst + (size_t)i * 512 + j0) = pack8f(v[0], v[1]); } }
    } break;
    case K_U: {
        const int h = o; bf16_t* dst = (bf16_t*)(X.ws + WS_VRH);
#pragma unroll
        for (int ai = 0; ai < 2; ++ai)
#pragma unroll
            for (int m = 0; m < 4; ++m) { const int e = 128 * ai + 16 * m + rl0; bf16_t* p = dst + ((size_t)(h * 64 + t) * 256 + e) * 512 + 256 + cl0;
#pragma unroll
                for (int bj = 0; bj < 2; ++bj) *(u32x4*)(p + 128 * bj) = pack8f(acc[ai][bj][m][0], acc[ai][bj][m][1]); }
    } break;
    case K_MAIN: {
        const int h = o; const float l2g = l2gamma(h);
        bf16_t* dst = (bf16_t*)X.out; f32x2* stat = (f32x2*)(X.ws + WS_STAT);
#pragma unroll
        for (int ai = 0; ai < 2; ++ai)
#pragma unroll
            for (int m = 0; m < 4; ++m) { const int i = 128 * ai + 16 * m + rl0, tok = 256 * t + i; const float xi = fast_exp2((float)(i + 1) * l2g);
                float s = 0.f, ss = 0.f;
#pragma unroll
                for (int bj = 0; bj < 2; ++bj) { f32x4 v0 = acc[ai][bj][m][0] * xi, v1 = acc[ai][bj][m][1] * xi;
#pragma unroll
                    for (int j = 0; j < 4; ++j) { s += v0[j] + v1[j]; ss += v0[j] * v0[j] + v1[j] * v1[j]; }
                    *(u32x4*)(dst + (size_t)tok * 2048 + h * 512 + g.hf * 256 + 128 * bj + cl0) = pack8f(v0, v1); }
                s += __shfl_xor(s, 16); s += __shfl_xor(s, 32); ss += __shfl_xor(ss, 16); ss += __shfl_xor(ss, 32);
                if (fq == 0) stat[(((size_t)tok * 4 + h) * 2 + g.hf) * 4 + wc] = (f32x2){s, ss};
            }
        if (g.hf == 1 && (wr | wc | fr | fq) == 0) __hip_atomic_fetch_add((unsigned*)(X.ws + WS_CTL) + CW_WAR, 1u, __ATOMIC_RELAXED, __HIP_MEMORY_SCOPE_AGENT);
    } break;
    case K_LOW: {
        bf16_t* CQ = (bf16_t*)(X.ws + WS_CQ); bf16_t* CKV = (bf16_t*)(X.ws + WS_CKV); bf16_t* KR = (bf16_t*)(X.ws + WS_KROPE); float* psq = (float*)(X.ws + WS_PSQ);
        int posv[2][4]; float fv[4];
        { const bool pe = (o == 2) && (cl0 < 64);
#pragma unroll
          for (int jj = 0; jj < 4; ++jj) fv[jj] = INVF[4 * (((cl0 & 63) >> 1) + jj)];
#pragma unroll
          for (int ai = 0; ai < 2; ++ai)
#pragma unroll
              for (int m = 0; m < 4; ++m) posv[ai][m] = pe ? posp[256 * t + 128 * ai + 16 * m + rl0] : 0;
          asm volatile("" : "+v"(fv[0]), "+v"(fv[1]), "+v"(fv[2]), "+v"(fv[3]), "+v"(posv[0][0]), "+v"(posv[0][1]), "+v"(posv[0][2]), "+v"(posv[0][3]), "+v"(posv[1][0]), "+v"(posv[1][1]), "+v"(posv[1][2]), "+v"(posv[1][3])); }
#pragma unroll
        for (int ai = 0; ai < 2; ++ai)
#pragma unroll
            for (int m = 0; m < 4; ++m) { const int tok = 256 * t + 128 * ai + 16 * m + rl0;
#pragma unroll
                for (int bj = 0; bj < 2; ++bj) { const int gcol = 256 * o + 128 * bj + cl0; const f32x4 v0 = acc[ai][bj][m][0], v1 = acc[ai][bj][m][1];
                    if (gcol < 640) {
                        float ss = 0.f;
#pragma unroll
                        for (int j = 0; j < 4; ++j) ss += v0[j] * v0[j] + v1[j] * v1[j];
                        ss += __shfl_xor(ss, 16); ss += __shfl_xor(ss, 32);
                        if (fq == 0) psq[(size_t)tok * 24 + (gcol >> 5)] = ss;
                        bf16_t* p = (gcol < 384) ? (CQ + (size_t)tok * 384 + gcol) : (CKV + (size_t)tok * 256 + (gcol - 384));
                        *(u32x4*)p = pack8f(v0, v1);
                    } else if (gcol < 704) {
                        const int i0 = (gcol - 640) >> 1; const float posf = (float)posv[ai][m]; f32x4 o1, o2;
#pragma unroll
                        for (int jj = 0; jj < 4; ++jj) { const float x1 = jj < 2 ? v0[2 * jj] : v1[2 * jj - 4], x2 = jj < 2 ? v0[2 * jj + 1] : v1[2 * jj - 3];
                            float s, c; sincos_ang(posf * fv[jj], s, c); o1[jj] = x1 * c - x2 * s; o2[jj] = x2 * c + x1 * s; }
                        u32x2 w1, w2; w1.x = cvt_pk_bf16(o1[0], o1[1]); w1.y = cvt_pk_bf16(o1[2], o1[3]); w2.x = cvt_pk_bf16(o2[0], o2[1]); w2.y = cvt_pk_bf16(o2[2], o2[3]);
                        *(u32x2*)(KR + (size_t)tok * 64 + i0) = w1; *(u32x2*)(KR + (size_t)tok * 64 + 32 + i0) = w2;
                    }
                } }
    } break;
    case K_QUP: {
        bf16_t* Q = (bf16_t*)(X.ws + WS_Q); const float* psq = (const float*)(X.ws + WS_PSQ);
        float fv[8];
#pragma unroll
        for (int j = 0; j < 8; ++j) fv[j] = INVF[4 * (8 * fq + j)];
        int posv[8];
#pragma unroll
        for (int q = 0; q < 8; ++q) posv[q] = (o >= 4) ? posp[256 * t + 128 * (q >> 2) + 16 * (q & 3) + rl0] : 0;
        PIN8(fv); PIN8(posv);
#pragma unroll
        for (int ai = 0; ai < 2; ++ai) {
            f32x4 sv[4][3];
#pragma unroll
            for (int m = 0; m < 4; ++m) { const int tok = 256 * t + 128 * ai + 16 * m + rl0; const f32x4* sp = (const f32x4*)(psq + (size_t)tok * 24);
                sv[m][0] = sp[0]; sv[m][1] = sp[1]; sv[m][2] = sp[2]; }
#pragma unroll
            for (int m = 0; m < 4; ++m) { const int tok = 256 * t + 128 * ai + 16 * m + rl0; const f32x4 s0 = sv[m][0], s1 = sv[m][1], s2 = sv[m][2];
                const float ssum = ((s0[0] + s0[1]) + (s0[2] + s0[3])) + ((s1[0] + s1[1]) + (s1[2] + s1[3])) + ((s2[0] + s2[1]) + (s2[2] + s2[3]));
                const float rs = __builtin_amdgcn_rsqf(ssum * (1.0f / 384.0f) + EPS) * QSCALE;
                if (o < 4) {
#pragma unroll
                    for (int bj = 0; bj < 2; ++bj) *(u32x4*)(Q + (size_t)tok * 1536 + (2 * o + bj) * 192 + cl0) = pack8f(acc[ai][bj][m][0] * rs, acc[ai][bj][m][1] * rs);
                } else {
                    const int head = (o - 4) * 4 + wc, i0 = 8 * fq; const float posf = (float)posv[4 * ai + m]; f32x4 o1[2], o2[2];
#pragma unroll
                    for (int n = 0; n < 2; ++n)
#pragma unroll
                        for (int j = 0; j < 4; ++j) { float s, c; sincos_ang(posf * fv[4 * n + j], s, c); const float x1 = acc[ai][0][m][n][j] * rs, x2 = acc[ai][1][m][n][j] * rs;
                            o1[n][j] = x1 * c - x2 * s; o2[n][j] = x2 * c + x1 * s; }
                    bf16_t* p = Q + (size_t)tok * 1536 + head * 192 + 128 + i0;
                    *(u32x4*)p = pack8f(o1[0], o1[1]); *(u32x4*)(p + 32) = pack8f(o2[0], o2[1]);
                }
            }
        }
    } break;
    case K_KVUP: {
        bf16_t* Kb = (bf16_t*)(X.ws + WS_K); bf16_t* Vb = (bf16_t*)(X.ws + WS_V); const float* psq = (const float*)(X.ws + WS_PSQ);
        const int tid = (wr * 4 + wc) * 64 + fq * 16 + fr, tokc = 256 * t + (tid >> 1), hsel = tid & 1;
        const u32x4* src = (const u32x4*)((const bf16_t*)(X.ws + WS_KROPE) + (size_t)tokc * 64 + hsel * 32);
        u32x4 rp[4];
#pragma unroll
        for (int q = 0; q < 4; ++q) rp[q] = src[q];
#pragma unroll
        for (int ai = 0; ai < 2; ++ai) {
            f32x4 sv[4][2];
#pragma unroll
            for (int m = 0; m < 4; ++m) { const int tok = 256 * t + 128 * ai + 16 * m + rl0; sv[m][0] = *(const f32x4*)(psq + (size_t)tok * 24 + 12); sv[m][1] = *(const f32x4*)(psq + (size_t)tok * 24 + 16); }
            if (ai == 0) { u32x4* dstp = (u32x4*)(Kb + (size_t)tokc * 1536 + o * 192 + 128 + hsel * 32);
#pragma unroll
                for (int q = 0; q < 4; ++q) dstp[q] = rp[q]; }
#pragma unroll
            for (int m = 0; m < 4; ++m) { const int tok = 256 * t + 128 * ai + 16 * m + rl0; const f32x4 s0 = sv[m][0], s1 = sv[m][1];
                const float ssum = ((s0[0] + s0[1]) + (s0[2] + s0[3])) + ((s1[0] + s1[1]) + (s1[2] + s1[3]));
                const float rs = __builtin_amdgcn_rsqf(ssum * (1.0f / 256.0f) + EPS);
                *(u32x4*)(Kb + (size_t)tok * 1536 + o * 192 + cl0) = pack8f(acc[ai][0][m][0] * rs, acc[ai][0][m][1] * rs);
                *(u32x4*)(Vb + (size_t)tok * 1024 + o * 128 + cl0) = pack8f(acc[ai][1][m][0] * rs, acc[ai][1][m][1] * rs);
            }
        }
    } break;
    case K_GMLA: {
        bf16_t* Ob = (bf16_t*)(X.ws + WS_O);
#pragma unroll
        for (int ai = 0; ai < 2; ++ai) {
            u32x4 ov[4][2];
#pragma unroll
            for (int m = 0; m < 4; ++m)
#pragma unroll
                for (int bj = 0; bj < 2; ++bj) ov[m][bj] = *(const u32x4*)(Ob + (size_t)(256 * t + 128 * ai + 16 * m + rl0) * 1024 + 256 * o + 128 * bj + cl0);
#pragma unroll
            for (int m = 0; m < 4; ++m) { const int tok = 256 * t + 128 * ai + 16 * m + rl0;
#pragma unroll
                for (int bj = 0; bj < 2; ++bj) { bf16_t* p = Ob + (size_t)tok * 1024 + 256 * o + 128 * bj + cl0; f32x4 a, b; unpack8(ov[m][bj], a, b);
#pragma unroll
                    for (int j = 0; j < 4; ++j) { a[j] *= siluf_(acc[ai][bj][m][0][j]); b[j] *= siluf_(acc[ai][bj][m][1][j]); }
                    *(u32x4*)p = pack8f(a, b); } }
        }
        if ((wr | wc) == 0) { const unsigned* ad = (const unsigned*)(X.ws + WS_CTL) + CW_ADONE; unsigned sp = 0;
            while ((unsigned)__builtin_amdgcn_readfirstlane((int)__hip_atomic_load(ad, __ATOMIC_RELAXED, __HIP_MEMORY_SCOPE_AGENT)) < 256u) { __builtin_amdgcn_s_sleep(4); if (++sp > (1u << 22)) break; } }
    } break;
    case K_GRET: {
        const float* const g_retp = INF(I_GRET);
        bf16_t* Ob = (bf16_t*)X.out; const float* stat = (const float*)(X.ws + WS_STAT); const int h = o >> 1;
        f32x4 gv[2][2];
#pragma unroll
        for (int bj = 0; bj < 2; ++bj) { gv[bj][0] = *(const f32x4*)(g_retp + 256 * o + 128 * bj + cl0); gv[bj][1] = *(const f32x4*)(g_retp + 256 * o + 128 * bj + cl0 + 4); }
#pragma unroll
        for (int ai = 0; ai < 2; ++ai)
#pragma unroll
            for (int mp = 0; mp < 2; ++mp) {
                f32x4 sq[2][4]; u32x4 ov[2][2];
#pragma unroll
                for (int mm = 0; mm < 2; ++mm) { const int tok = 256 * t + 128 * ai + 16 * (2 * mp + mm) + rl0; const f32x4* sp = (const f32x4*)(stat + ((size_t)tok * 4 + h) * 16);
                    sq[mm][0] = sp[0]; sq[mm][1] = sp[1]; sq[mm][2] = sp[2]; sq[mm][3] = sp[3];
#pragma unroll
                    for (int bj = 0; bj < 2; ++bj) ov[mm][bj] = *(const u32x4*)(Ob + (size_t)tok * 2048 + 256 * o + 128 * bj + cl0); }
#pragma unroll
                for (int mm = 0; mm < 2; ++mm) { const int m = 2 * mp + mm, tok = 256 * t + 128 * ai + 16 * m + rl0; const f32x4 q0 = sq[mm][0], q1 = sq[mm][1], q2 = sq[mm][2], q3 = sq[mm][3];
                    const float s = ((q0[0] + q0[2]) + (q1[0] + q1[2])) + ((q2[0] + q2[2]) + (q3[0] + q3[2])), ss = ((q0[1] + q0[3]) + (q1[1] + q1[3])) + ((q2[1] + q2[3]) + (q3[1] + q3[3]));
                    const float mean = s * (1.0f / 512.0f); const float var = __builtin_fmaxf(ss * (1.0f / 512.0f) - mean * mean, 0.0f); const float rstd = __builtin_amdgcn_rsqf(var + EPS);
#pragma unroll
                    for (int bj = 0; bj < 2; ++bj) { bf16_t* p = Ob + (size_t)tok * 2048 + 256 * o + 128 * bj + cl0; f32x4 a, b; unpack8(ov[mm][bj], a, b);
#pragma unroll
                        for (int j = 0; j < 4; ++j) { a[j] = (a[j] - mean) * rstd * gv[bj][0][j] * siluf_(acc[ai][bj][m][0][j]); b[j] = (b[j] - mean) * rstd * gv[bj][1][j] * siluf_(acc[ai][bj][m][1][j]); }
                        *(u32x4*)p = pack8f(a, b); } }
            }
    } break;
    case K_P0: case K_P2: case K_P1: case K_P3: {
        const int tid = (wr * 4 + wc) * 64 + fq * 16 + fr; const size_t so = (size_t)blockIdx.x * 16 * 512 + tid;
        u32x4* sa1 = (u32x4*)(X.ws + WS_SCRA) + so; u32x4* sb = (u32x4*)(X.ws + WS_SCRB) + so; u32x4* sa2 = (u32x4*)(X.ws + WS_SCRA2) + so;
        bf16_t* Mg = (bf16_t*)(X.ws + WS_MERGED);
        if (g.kind == K_P0 || g.kind == K_P2) {
            u32x4* sa = (g.kind == K_P0) ? sa1 : sa2;
#pragma unroll
            for (int ai = 0; ai < 2; ++ai)
#pragma unroll
                for (int bj = 0; bj < 2; ++bj)
#pragma unroll
                    for (int m = 0; m < 4; ++m) { const int rj = (ai * 2 + bj) * 4 + m; const f32x4 a = acc[ai][bj][m][0], b = acc[ai][bj][m][1]; u32x4 w;
                        w.x = cvt_pk_bf16(sigmoidf_(a[0]), sigmoidf_(a[1])); w.y = cvt_pk_bf16(sigmoidf_(a[2]), sigmoidf_(a[3]));
                        w.z = cvt_pk_bf16(sigmoidf_(b[0]), sigmoidf_(b[1])); w.w = cvt_pk_bf16(sigmoidf_(b[2]), sigmoidf_(b[3])); sa[(size_t)rj * 512] = w; }
        } else {
            const u32x4* sa = (g.kind == K_P1) ? sa1 : sa2;
#pragma unroll
            for (int ai = 0; ai < 2; ++ai) {
                u32x4 gw[2][4], tv[2][4];
#pragma unroll
                for (int bj = 0; bj < 2; ++bj)
#pragma unroll
                    for (int m = 0; m < 4; ++m) { const int rj = (ai * 2 + bj) * 4 + m; gw[bj][m] = sa[(size_t)rj * 512]; if (g.kind == K_P3) tv[bj][m] = sb[(size_t)rj * 512]; }
#pragma unroll
                for (int bj = 0; bj < 2; ++bj)
#pragma unroll
                    for (int m = 0; m < 4; ++m) { const int rj = (ai * 2 + bj) * 4 + m; f32x4 g0, g1; unpack8(gw[bj][m], g0, g1);
                        const f32x4 p0 = g0 * acc[ai][bj][m][0], p1 = g1 * acc[ai][bj][m][1];
                        if (g.kind == K_P1) sb[(size_t)rj * 512] = pack8f(p0, p1);
                        else { f32x4 t0, t1; unpack8(tv[bj][m], t0, t1); const int tok = 256 * t + 128 * ai + 16 * m + rl0;
                            *(u32x4*)(Mg + (size_t)tok * 1024 + 256 * o + 128 * bj + cl0) = pack8f(t0 + p0, t1 + p1); } }
            }
        }
    } break;
    default: break;
    }
}

__device__ __forceinline__ void epilogue_final(const Ctx& X0, f32x4 (&acc)[2][2][4][2], const Unit& u, int wr, int wc, int fr, int fq, LAS unsigned char* lds) {
    size_t z_ = 0; asm volatile("" : "+s"(z_));
    struct { unsigned char* ws; float* out; } X = {X0.ws + z_, X0.out + z_};
    asm volatile("" : "+s"(wr), "+s"(wc), "+v"(fr), "+v"(fq));
    const int t = u.t, o = u.o, cl0 = 32 * wc + 8 * fq, rl0 = 64 * wr + fr, tid = (wr * 4 + wc) * 64 + fq * 16 + fr;
    const float* const xp = INF(I_X);
    const float* gate = (const float*)(X.ws + WS_MOD) + 2048; float* fsq = (float*)(X.ws + WS_FSQ);
    unsigned* cnt = (unsigned*)(X.ws + WS_CTL) + CW_CNT + 64 * t;
    LAS u32x2* slot = (LAS u32x2*)lds + tid;
    { f32x4 gv[2][2];
#pragma unroll
    for (int bj = 0; bj < 2; ++bj) { gv[bj][0] = *(const f32x4*)(gate + 256 * o + 128 * bj + cl0); gv[bj][1] = *(const f32x4*)(gate + 256 * o + 128 * bj + cl0 + 4); }
    f32x4 xv[2][2][2][2];
#define XLOAD(b_) do { _Pragma("unroll") for (int mm = 0; mm < 2; ++mm) _Pragma("unroll") for (int bj = 0; bj < 2; ++bj) _Pragma("unroll") for (int n = 0; n < 2; ++n) \
        xv[(b_) & 1][mm][bj][n] = *(const f32x4*)(xp + (size_t)(256 * t + 128 * ((b_) >> 1) + 16 * (2 * ((b_) & 1) + mm) + rl0) * 1024 + 256 * o + 128 * bj + cl0 + 4 * n); } while (0)
    XLOAD(0);
#pragma unroll
    for (int b = 0; b < 4; ++b) { const int ai = b >> 1, mp = b & 1;
        if (b + 1 < 4) XLOAD(b + 1);
#pragma unroll
        for (int mm = 0; mm < 2; ++mm) { const int m = 2 * mp + mm, tok = 256 * t + 128 * ai + 16 * m + rl0; float ss = 0.f;
#pragma unroll
            for (int bj = 0; bj < 2; ++bj)
#pragma unroll
                for (int n = 0; n < 2; ++n) {
                    const f32x4 v = xv[b & 1][mm][bj][n] + gv[bj][n] * acc[ai][bj][m][n]; u32x2 w; w.x = cvt_pk_bf16(v[0], v[1]); w.y = cvt_pk_bf16(v[2], v[3]);
                    const f32x4 vr = {bflo(w.x), bfhi(w.x), bflo(w.y), bfhi(w.y)};
                    ss += (vr[0] * vr[0] + vr[1] * vr[1]) + (vr[2] * vr[2] + vr[3] * vr[3]); slot[(((ai * 2 + bj) * 4 + m) * 2 + n) * 512] = w; }
            ss += __shfl_xor(ss, 16); ss += __shfl_xor(ss, 32);
            if (fq == 0) __hip_atomic_store(fsq + (size_t)tok * 16 + 4 * o + wc, ss, __ATOMIC_RELAXED, __HIP_MEMORY_SCOPE_AGENT); } }
#undef XLOAD
    }
    asm volatile("s_waitcnt vmcnt(0)" ::: "memory");
    if (fq == 0 && fr == 0) __hip_atomic_fetch_add(cnt, 1u, __ATOMIC_RELAXED, __HIP_MEMORY_SCOPE_AGENT);
    { unsigned sp = 0;
      while ((unsigned)__builtin_amdgcn_readfirstlane((int)__hip_atomic_load(cnt, __ATOMIC_RELAXED, __HIP_MEMORY_SCOPE_AGENT)) < 32u) { __builtin_amdgcn_s_sleep(4); if (++sp > (1u << 22)) break; } }
    __builtin_amdgcn_fence(__ATOMIC_ACQUIRE, "agent");
    { const float* const gfin = INF(I_GFINAL);
    f32x4 gf[2][2];
#pragma unroll
    for (int bj = 0; bj < 2; ++bj) { gf[bj][0] = *(const f32x4*)(gfin + 256 * o + 128 * bj + cl0); gf[bj][1] = *(const f32x4*)(gfin + 256 * o + 128 * bj + cl0 + 4); }
    float rstd[2][4];
    { f32x4 fv[2][4][4];
#pragma unroll
      for (int ai = 0; ai < 2; ++ai)
#pragma unroll
          for (int m = 0; m < 4; ++m) { const f32x4* sp = (const f32x4*)(fsq + (size_t)(256 * t + 128 * ai + 16 * m + rl0) * 16); fv[ai][m][0] = sp[0]; fv[ai][m][1] = sp[1]; fv[ai][m][2] = sp[2]; fv[ai][m][3] = sp[3]; }
#pragma unroll
      for (int ai = 0; ai < 2; ++ai)
#pragma unroll
          for (int m = 0; m < 4; ++m) { const f32x4 a = fv[ai][m][0], b = fv[ai][m][1], c = fv[ai][m][2], d = fv[ai][m][3];
              const float ss = (((a[0] + a[1]) + (a[2] + a[3])) + ((b[0] + b[1]) + (b[2] + b[3]))) + (((c[0] + c[1]) + (c[2] + c[3])) + ((d[0] + d[1]) + (d[2] + d[3])));
              rstd[ai][m] = __builtin_amdgcn_rsqf(ss * (1.0f / DM) + EPS); } }
#pragma unroll
    for (int ai = 0; ai < 2; ++ai)
#pragma unroll
        for (int m = 0; m < 4; ++m) { const int tok = 256 * t + 128 * ai + 16 * m + rl0;
#pragma unroll
            for (int bj = 0; bj < 2; ++bj)
#pragma unroll
                for (int n = 0; n < 2; ++n) { const u32x2 w = slot[(((ai * 2 + bj) * 4 + m) * 2 + n) * 512]; const f32x4 v = {bflo(w.x), bfhi(w.x), bflo(w.y), bfhi(w.y)};
                    *(f32x4*)(X.out + (size_t)tok * 1024 + 256 * o + 128 * bj + cl0 + 4 * n) = v * rstd[ai][m] * gf[bj][n]; }
            asm volatile("" ::: "memory"); } }
}

struct Step;
__device__ __forceinline__ GCall step_call(int si);
__device__ __forceinline__ void gemm_stream(LAS unsigned char* lds, int s0, int ns, const Ctx& X) {
    const int tid = X.tid, wid = __builtin_amdgcn_readfirstlane(tid >> 6), lane = tid & 63, wr = wid >> 2, wc = wid & 3, fr = lane & 15, fq = lane >> 4;
#define PG8_VOFF(VA, VB, lda_, ldb_) do { int t_ = tid; asm volatile("" : "+v"(t_)); _Pragma("unroll") for (int i = 0; i < 2; ++i) { int R_, C_; stage_rc(t_ * 16 + i * 8192, R_, C_); \
        const int Rb_ = (R_ & ~31) + perm32(R_ & 31); VA[i] = (unsigned)(R_ * (lda_) + C_) * 2u; VB[i] = (unsigned)(Rb_ * (ldb_) + C_) * 2u; } } while (0)
    const size_t kstep = (size_t)(BK * 2);
    const unsigned ldsw = (unsigned)wid * 1024u;
    const int aoff = lds_byte(wr * 64 + fr, fq * 8), boff = lds_byte(wc * 32 + fr, fq * 8);
#define PG8_SA(b, h) (((b) * 2 + (h)) * HTB)
#define PG8_SB(b, h) ((4 + (b) * 2 + (h)) * HTB)
#define PG8_STAGE(bufoff, gbase, voff) do { _Pragma("unroll") for (int _i = 0; _i < 2; ++_i) \
        __builtin_amdgcn_global_load_lds((const unsigned*)((const char*)(gbase) + (voff)[_i]), (LAS unsigned*)(lds + (bufoff) + ldsw + _i * 8192), 16, 0, 0); } while (0)
#define PG8_LDA(dst, b, h) do { _Pragma("unroll") for (int m = 0; m < 4; ++m) _Pragma("unroll") for (int k = 0; k < 2; ++k) dst[m][k] = *(const LAS bf16x8*)(lds + PG8_SA(b, h) + aoff + m * 2048 + k * 1024); } while (0)
#define PG8_LDB(dst, b, h) do { _Pragma("unroll") for (int n = 0; n < 2; ++n) _Pragma("unroll") for (int k = 0; k < 2; ++k) dst[n][k] = *(const LAS bf16x8*)(lds + PG8_SB(b, h) + boff + n * 2048 + k * 1024); } while (0)
#define PG8_MMA(ai, bj, At, Bt) do { __builtin_amdgcn_s_setprio(1); _Pragma("unroll") for (int m = 0; m < 4; ++m) _Pragma("unroll") for (int n = 0; n < 2; ++n) _Pragma("unroll") for (int k = 0; k < 2; ++k) \
        acc[ai][bj][m][n] = __builtin_amdgcn_mfma_f32_16x16x32_bf16(Bt[n][k], At[m][k], acc[ai][bj][m][n], 0, 0, 0); __builtin_amdgcn_s_setprio(0); } while (0)
#define PG8_WAIT_V(n) asm volatile("s_waitcnt vmcnt(" #n ")" ::: "memory")
#define PG8_WAIT_L(n) asm volatile("s_waitcnt lgkmcnt(" #n ")" ::: "memory")
#define PG8_BAR __builtin_amdgcn_s_barrier()
#define PG8_SCHED __builtin_amdgcn_sched_barrier(0)
#define PG8_KBODY(a1, a2, a3, b2, b3, VA2, VB2, HA2, HB2) do { \
        PG8_LDB(B0, 0, 0); PG8_LDB(B1, 0, 1); PG8_SCHED; PG8_LDA(At, 0, 0); PG8_STAGE(PG8_SA(1, 1), (a1) + hstepA, voffA); \
        PG8_WAIT_V(8); PG8_WAIT_L(0); PG8_BAR; PG8_MMA(0, 0, At, B0); PG8_MMA(0, 1, At, B1); PG8_BAR; PG8_SCHED; \
        PG8_LDA(At, 0, 1); PG8_STAGE(PG8_SB(0, 0), (b2), VB2); PG8_STAGE(PG8_SB(0, 1), (b2) + (HB2), VB2); PG8_STAGE(PG8_SA(0, 0), (a2), VA2); \
        PG8_WAIT_V(8); PG8_WAIT_L(0); PG8_BAR; PG8_MMA(1, 0, At, B0); PG8_MMA(1, 1, At, B1); PG8_BAR; PG8_SCHED; \
        PG8_LDB(B0, 1, 0); PG8_LDB(B1, 1, 1); PG8_SCHED; PG8_LDA(At, 1, 0); PG8_STAGE(PG8_SA(0, 1), (a2) + (HA2), VA2); \
        PG8_WAIT_V(8); PG8_WAIT_L(0); PG8_BAR; PG8_MMA(0, 0, At, B0); PG8_MMA(0, 1, At, B1); PG8_BAR; PG8_SCHED; \
        PG8_LDA(At, 1, 1); PG8_STAGE(PG8_SB(1, 0), (b3), VB2); PG8_STAGE(PG8_SB(1, 1), (b3) + (HB2), VB2); PG8_STAGE(PG8_SA(1, 0), (a3), VA2); \
        PG8_WAIT_V(8); PG8_WAIT_L(0); PG8_BAR; PG8_MMA(1, 0, At, B0); PG8_MMA(1, 1, At, B1); PG8_BAR; PG8_SCHED; } while (0)
    int seg = 0, ui = 0; GCall g = step_call(s0); Unit cur;
    while (!unit_next(g, X.vcu, ui, cur)) { if (++seg >= ns) return; g = step_call(s0 + seg); ui = 0; }
    unsigned voffA[2], voffB[2], nvoffA[2], nvoffB[2];
    PG8_VOFF(voffA, voffB, g.lda, g.ldb);
    size_t hstepA = (size_t)HALF * g.lda * 2, hstepB = (size_t)HALF * g.ldb * 2;
    int nt = g.K / BK;
    f32x4 acc[2][2][4][2];
#pragma unroll
    for (int a = 0; a < 2; ++a)
#pragma unroll
        for (int b = 0; b < 2; ++b)
#pragma unroll
            for (int m = 0; m < 4; ++m)
#pragma unroll
                for (int n = 0; n < 2; ++n) acc[a][b][m][n] = (f32x4){0.f, 0.f, 0.f, 0.f};
    bf16x8 At[4][2], B0[2][2], B1[2][2];
    const char* cA; const char* cB; unit_ptrs(g, X, cur, cA, cB);
    PG8_STAGE(PG8_SB(0, 0), cB, voffB); PG8_STAGE(PG8_SB(0, 1), cB + hstepB, voffB); PG8_STAGE(PG8_SA(0, 0), cA, voffA); PG8_STAGE(PG8_SA(0, 1), cA + hstepA, voffA);
    if (wr == 1) PG8_BAR;
    PG8_WAIT_V(2); PG8_BAR;
    PG8_STAGE(PG8_SB(1, 0), cB + kstep, voffB); PG8_STAGE(PG8_SA(1, 0), cA + kstep, voffA); PG8_STAGE(PG8_SB(1, 1), cB + hstepB + kstep, voffB);
    PG8_WAIT_V(6); PG8_BAR;
    for (;;) {
        GCall ng = g; Unit nxt; int nseg = seg, nui = ui + 1; bool has_next = true;
        while (!unit_next(ng, X.vcu, nui, nxt)) { if (++nseg >= ns) { has_next = false; break; } ng = step_call(s0 + nseg); nui = 0; }
        const char* nA = cA; const char* nB = cB; size_t nhstepA = hstepA, nhstepB = hstepB;
#pragma unroll
        for (int i = 0; i < 2; ++i) { nvoffA[i] = voffA[i]; nvoffB[i] = voffB[i]; }
        if (has_next) { unit_ptrs(ng, X, nxt, nA, nB); nhstepA = (size_t)HALF * ng.lda * 2; nhstepB = (size_t)HALF * ng.ldb * 2;
            if (nseg != seg) PG8_VOFF(nvoffA, nvoffB, ng.lda, ng.ldb); }
        for (int t = 0; t < nt - 2; t += 2) {
            const char* a1 = cA + (size_t)(t + 1) * kstep; const char* a2 = cA + (size_t)(t + 2) * kstep; const char* b2 = cB + (size_t)(t + 2) * kstep;
            PG8_KBODY(a1, a2, a2 + kstep, b2, b2 + kstep, voffA, voffB, hstepA, hstepB);
        }
        { const char* a1 = cA + (size_t)(nt - 1) * kstep;
          PG8_KBODY(a1, nA, nA + kstep, nB, nB + kstep, nvoffA, nvoffB, nhstepA, nhstepB); }
        if (wr == 0) PG8_BAR;
        if (g.kind != K_FINAL) epilogue(g, X, acc, cur, wr, wc, fr, fq);
        if (!has_next) break;
#pragma unroll
        for (int a = 0; a < 2; ++a)
#pragma unroll
            for (int b = 0; b < 2; ++b)
#pragma unroll
                for (int m = 0; m < 4; ++m)
#pragma unroll
                    for (int n = 0; n < 2; ++n) acc[a][b][m][n] = (f32x4){0.f, 0.f, 0.f, 0.f};
        cur = nxt; cA = nA; cB = nB; g = ng; seg = nseg; ui = nui; hstepA = nhstepA; hstepB = nhstepB; nt = g.K / BK;
#pragma unroll
        for (int i = 0; i < 2; ++i) { voffA[i] = nvoffA[i]; voffB[i] = nvoffB[i]; }
        if (wr == 1) PG8_BAR;
    }
    PG8_WAIT_V(0);
    PG8_BAR;
    if (g.kind == K_FINAL) epilogue_final(X, acc, cur, wr, wc, fr, fq, lds);
#undef PG8_KBODY
#undef PG8_VOFF
#undef PG8_SA
#undef PG8_SB
#undef PG8_STAGE
#undef PG8_LDA
#undef PG8_LDB
#undef PG8_MMA
#undef PG8_WAIT_V
#undef PG8_WAIT_L
#undef PG8_BAR
#undef PG8_SCHED
}

namespace att16 {
constexpr int QP = 1536, VP = 1024, OP = 1024;
constexpr int KROWB = 416, VROWB = 288;
constexpr int SHM_K = 64 * KROWB, SHM_V = 64 * VROWB;
constexpr int LDS_V = 0, LDS_K = 2 * SHM_V, LDS_TOTAL = LDS_K + 2 * SHM_K;
constexpr float THR2 = 11.5f;
typedef __attribute__((address_space(3))) const char* lds_cptr;
typedef short v4i16_t __attribute__((ext_vector_type(4)));
#define SBAR() __builtin_amdgcn_sched_barrier(0)
__device__ __forceinline__ s16x4 vtr(lds_cptr p) { return __builtin_bit_cast(s16x4, __builtin_amdgcn_ds_read_tr16_b64_v4i16((__attribute__((address_space(3))) v4i16_t*)p)); }
__device__ __forceinline__ bf16x8 kfr(lds_cptr p) { return *(const __attribute__((address_space(3))) bf16x8*)p; }
__device__ __forceinline__ float xmax16(float x) {
    auto r = __builtin_amdgcn_permlane16_swap(__float_as_uint(x), __float_as_uint(x), false, false); x = fmaxf(__uint_as_float(r[0]), __uint_as_float(r[1]));
    auto r2 = __builtin_amdgcn_permlane32_swap(__float_as_uint(x), __float_as_uint(x), false, false); return fmaxf(__uint_as_float(r2[0]), __uint_as_float(r2[1]));
}
__device__ __forceinline__ float xsum16(float x) {
    auto r = __builtin_amdgcn_permlane16_swap(__float_as_uint(x), __float_as_uint(x), false, false); x = __uint_as_float(r[0]) + __uint_as_float(r[1]);
    auto r2 = __builtin_amdgcn_permlane32_swap(__float_as_uint(x), __float_as_uint(x), false, false); return __uint_as_float(r2[0]) + __uint_as_float(r2[1]);
}
#define MM16(acc_, a_, b_) acc_ = __builtin_amdgcn_mfma_f32_16x16x32_bf16(a_, b_, acc_, 0, 0, 0)
__device__ __forceinline__ void attn_unit(const bf16_t* Qh, const bf16_t* Kh, const bf16_t* Vh, bf16_t* Oh, int q0, char* lds, int tid) {
    asm volatile("" : "+v"(tid));
    const int wid = __builtin_amdgcn_readfirstlane(tid >> 6), lane = tid & 63, c = lane & 15, g = lane >> 4;
    const int NT = (q0 + 256) / 64;
    const int qlo = q0 + wid * 32;
    char* V_lds = lds + LDS_V; char* K_lds = lds + LDS_K;
    const int sr = tid >> 4, sc = (tid & 15) * 8, vst0 = sr * VROWB + sc * 2;
    int krc[3];
#pragma unroll
    for (int i = 0; i < 3; ++i) { const int q = tid + 512 * i, row = q / 24, cc = q - row * 24; krc[i] = (row << 5) | cc; }
    const lds_cptr l3 = (lds_cptr)lds;
    const lds_cptr kp0 = l3 + LDS_K + c * KROWB + g * 16;
    const lds_cptr vp0 = l3 + LDS_V + (4 * g + (c >> 2)) * VROWB + 8 * (c & 3);
    bf16x8 qf[2][6];
#pragma unroll
    for (int qb = 0; qb < 2; ++qb)
#pragma unroll
        for (int ks = 0; ks < 6; ++ks) qf[qb][ks] = *reinterpret_cast<const bf16x8*>(Qh + (size_t)(qlo + 16 * qb + c) * QP + 32 * ks + 8 * g);
    bf16x8 sa0, sa1, sa2, sb0, sb1, sb2, sv0, sv1;
#define KOFF(i, rowmul, ccmul) ({ int k_ = krc[i]; asm volatile("" : "+v"(k_)); (k_ >> 5) * (rowmul) + (k_ & 31) * (ccmul); })
#define KLOAD(tt, k0_, k1_, k2_) do { const bf16_t* kp_ = Kh + (size_t)(tt) * 64 * QP; \
        k0_ = *reinterpret_cast<const bf16x8*>(kp_ + KOFF(0, QP, 8)); k1_ = *reinterpret_cast<const bf16x8*>(kp_ + KOFF(1, QP, 8)); k2_ = *reinterpret_cast<const bf16x8*>(kp_ + KOFF(2, QP, 8)); } while (0)
#define VLOAD(tt) do { const bf16_t* vp_ = Vh + (size_t)(tt) * 64 * VP + (size_t)sr * VP + sc; sv0 = *reinterpret_cast<const bf16x8*>(vp_); sv1 = *reinterpret_cast<const bf16x8*>(vp_ + 32 * VP); } while (0)
#define KWRITE(ko, k0_, k1_, k2_) do { *(bf16x8*)(K_lds + (ko) + KOFF(0, KROWB, 16)) = k0_; *(bf16x8*)(K_lds + (ko) + KOFF(1, KROWB, 16)) = k1_; *(bf16x8*)(K_lds + (ko) + KOFF(2, KROWB, 16)) = k2_; } while (0)
#define VWRITE(vo) do { *(bf16x8*)(V_lds + (vo) + vst0) = sv0; *(bf16x8*)(V_lds + (vo) + vst0 + 32 * VROWB) = sv1; } while (0)
    float m_reg[2] = {0.f, 0.f}, l_reg[2] = {0.f, 0.f};
    f32x4 o[8][2];
#pragma unroll
    for (int db = 0; db < 8; ++db) { o[db][0] = (f32x4){0.f, 0.f, 0.f, 0.f}; o[db][1] = (f32x4){0.f, 0.f, 0.f, 0.f}; }
    KLOAD(0, sa0, sa1, sa2); VLOAD(0); KWRITE(0, sa0, sa1, sa2); VWRITE(0); KLOAD(1, sa0, sa1, sa2); VLOAD(1); KLOAD(2, sb0, sb1, sb2); __syncthreads();
    int kcur = 0, vcur = 0;
#define ASTEP(t, k0_, k1_, k2_) do { \
        SBAR(); \
        step_s(t); \
        SBAR(); \
        step_pv(t); \
        SBAR(); \
        KWRITE(kcur ^ SHM_K, k0_, k1_, k2_); VWRITE(vcur ^ SHM_V);     \
        KLOAD(min((t) + 3, NT - 1), k0_, k1_, k2_);                       \
        VLOAD(min((t) + 2, NT - 1)); \
        __syncthreads(); \
        kcur ^= SHM_K; vcur ^= SHM_V; } while (0)
    bf16x8 pf[2][2]; bool act;
    auto step_s = [&](int t) __attribute__((always_inline)) {
        act = 64 * t <= qlo + 31;
        if (act) {
        f32x4 s[4][2];
#pragma unroll
        for (int kb = 0; kb < 4; ++kb) { s[kb][0] = (f32x4){-m_reg[0], -m_reg[0], -m_reg[0], -m_reg[0]}; s[kb][1] = (f32x4){-m_reg[1], -m_reg[1], -m_reg[1], -m_reg[1]}; }
        { const lds_cptr kp = kp0 + kcur; bf16x8 kf[4];
#pragma unroll
          for (int kb = 0; kb < 4; ++kb) kf[kb] = kfr(kp + kb * 16 * KROWB);
          SBAR();
#pragma unroll
          for (int ks = 0; ks < 6; ++ks)
#pragma unroll
              for (int kb = 0; kb < 4; ++kb) { MM16(s[kb][0], kf[kb], qf[0][ks]); MM16(s[kb][1], kf[kb], qf[1][ks]);
                  if (ks < 5) kf[kb] = kfr(kp + kb * 16 * KROWB + (ks + 1) * 64);
                  SBAR(); } }
        if (64 * t + 63 > qlo) {
            const float NEG = -__builtin_inff();
#pragma unroll
            for (int kb = 0; kb < 4; ++kb)
#pragma unroll
                for (int qb = 0; qb < 2; ++qb)
#pragma unroll
                    for (int r = 0; r < 4; ++r) if (64 * t + 16 * kb + 4 * g + r > qlo + 16 * qb + c) s[kb][qb][r] = NEG;
        }
        float pm[2];
#pragma unroll
        for (int qb = 0; qb < 2; ++qb) { float a = fmaxf(fmaxf(s[0][qb][0], s[0][qb][1]), s[0][qb][2]), b = fmaxf(fmaxf(s[0][qb][3], s[1][qb][0]), s[1][qb][1]);
            a = fmaxf(fmaxf(a, s[1][qb][2]), s[1][qb][3]); b = fmaxf(fmaxf(b, s[2][qb][0]), s[2][qb][1]); a = fmaxf(fmaxf(a, s[2][qb][2]), s[2][qb][3]);
            b = fmaxf(fmaxf(b, s[3][qb][0]), s[3][qb][1]); a = fmaxf(fmaxf(a, s[3][qb][2]), s[3][qb][3]); pm[qb] = xmax16(fmaxf(a, b)); }
        if (__builtin_expect(t == 0 || !__all(fmaxf(pm[0], pm[1]) <= THR2), 0)) {
#pragma unroll
            for (int qb = 0; qb < 2; ++qb) { const float d = (t == 0) ? pm[qb] : fmaxf(pm[qb], 0.f); const float al = __builtin_amdgcn_exp2f(-d); m_reg[qb] += d; l_reg[qb] *= al;
#pragma unroll
                for (int kb = 0; kb < 4; ++kb) s[kb][qb] -= d;
#pragma unroll
                for (int db = 0; db < 8; ++db) o[db][qb] *= al; }
        }
#pragma unroll
        for (int qb = 0; qb < 2; ++qb) {
#pragma unroll
            for (int kb = 0; kb < 4; ++kb)
#pragma unroll
                for (int r = 0; r < 4; ++r) s[kb][qb][r] = __builtin_amdgcn_exp2f(s[kb][qb][r]);
            f32x2 s2 = {s[0][qb][0], s[0][qb][1]}; s2 += (f32x2){s[0][qb][2], s[0][qb][3]};
#pragma unroll
            for (int kb = 1; kb < 4; ++kb) { s2 += (f32x2){s[kb][qb][0], s[kb][qb][1]}; s2 += (f32x2){s[kb][qb][2], s[kb][qb][3]}; }
            l_reg[qb] += s2[0] + s2[1];
#pragma unroll
            for (int sp = 0; sp < 2; ++sp) { u32x4 w; w.x = cvt_pk_bf16(s[2 * sp][qb][0], s[2 * sp][qb][1]); w.y = cvt_pk_bf16(s[2 * sp][qb][2], s[2 * sp][qb][3]);
                w.z = cvt_pk_bf16(s[2 * sp + 1][qb][0], s[2 * sp + 1][qb][1]); w.w = cvt_pk_bf16(s[2 * sp + 1][qb][2], s[2 * sp + 1][qb][3]); pf[sp][qb] = *reinterpret_cast<bf16x8*>(&w); }
        }
        }
    };
    auto step_pv = [&](int t) __attribute__((always_inline)) {
        if (act)
        { const lds_cptr vp = vp0 + vcur; s16x4 vl[3], vh[3];
#pragma unroll
          for (int db = 0; db < 3; ++db) { vl[db] = vtr(vp + 32 * db); vh[db] = vtr(vp + 16 * VROWB + 32 * db); }
          SBAR();
#pragma unroll
          for (int i = 0; i < 16; ++i) { const int sp = i >> 3, db = i & 7, sl = i % 3;
              const bf16x8 vf = (bf16x8){vl[sl][0], vl[sl][1], vl[sl][2], vl[sl][3], vh[sl][0], vh[sl][1], vh[sl][2], vh[sl][3]};
              MM16(o[db][0], vf, pf[sp][0]); MM16(o[db][1], vf, pf[sp][1]);
              if (i + 3 < 16) { const int sp2 = (i + 3) >> 3, db2 = (i + 3) & 7; vl[sl] = vtr(vp + (32 * sp2) * VROWB + 32 * db2); vh[sl] = vtr(vp + (32 * sp2 + 16) * VROWB + 32 * db2); }
              SBAR(); } }
    };
    for (int t = 0; t < NT; t += 2) {
        ASTEP(t, sa0, sa1, sa2);
        ASTEP(t + 1, sb0, sb1, sb2);
    }
#undef ASTEP
#undef KLOAD
#undef VLOAD
#undef KWRITE
#undef VWRITE
#undef KOFF
#pragma unroll
    for (int qb = 0; qb < 2; ++qb) { const float rl = __builtin_amdgcn_rcpf(xsum16(l_reg[qb])); bf16_t* Ow = Oh + (size_t)(qlo + 16 * qb + c) * OP + 8 * (g >> 1) + 16 * (g & 1);
#pragma unroll
        for (int j = 0; j < 4; ++j) { const f32x4 ve = o[2 * j][qb] * rl, vo = o[2 * j + 1][qb] * rl;
            const unsigned ex = cvt_pk_bf16(ve[0], ve[1]), ey = cvt_pk_bf16(ve[2], ve[3]), ox = cvt_pk_bf16(vo[0], vo[1]), oy = cvt_pk_bf16(vo[2], vo[3]);
            auto rx = __builtin_amdgcn_permlane16_swap(ex, ox, false, false); auto ry = __builtin_amdgcn_permlane16_swap(ey, oy, false, false);
            u32x4 w; w.x = rx[0]; w.y = ry[0]; w.z = rx[1]; w.w = ry[1]; *(u32x4*)(Ow + 32 * j) = w; } }
    __syncthreads();
}
#undef SBAR
#undef MM16
}

__device__ __forceinline__ int win_src(int n) {
    if (n < 1024) return 1728 + n;
    if (n < 2048) return 2752 + (n - 1024);
    if (n < 4096) return 3776 + (n - 2048);
    if (n < 6144) return 5824 + (n - 4096);
    if (n < 7168) return 704 + (n - 6144);
    if (n < 8192) return 7872 + (n - 7168);
    if (n < 9216) return 8896 + (n - 8192);
    const int m = n - 9216;
    if (m < 640) return m;
    if (m < 704) { const int p = m - 640; return 640 + ((p & 1) ? 32 + (p >> 1) : (p >> 1)); }
    return -1;
}
__device__ __forceinline__ int wq_src(int n) {
    if (n < 1024) { const int t = n >> 8, bj = (n >> 7) & 1, i = n & 127; return (2 * t + bj) * 192 + i; }
    const int m = n - 1024, t4 = m >> 8, bj = (m >> 7) & 1, hh = (m >> 5) & 3, i = m & 31; return (t4 * 4 + hh) * 192 + 128 + bj * 32 + i;
}
template <int WHICH, bool SC>
__device__ __forceinline__ void transpose_item(const float* W, int K, int Nsrc, int nkb, const float* kscale, bf16_t* WT, LAS float* scr, int item, int lane) {
    const int nb = item / nkb, kb = item - nb * nkb, k0 = 64 * kb, n0 = 64 * nb;
    float tv[2][32];
#pragma unroll
    for (int s = 0; s < 2; ++s) { const int n = n0 + 32 * s + (lane & 31); const int src = WHICH == 0 ? win_src(n) : WHICH == 1 ? wq_src(n) : n;
#pragma unroll
        for (int i = 0; i < 32; ++i) { const int kk = 2 * i + (lane >> 5); float v = 0.f; if (src >= 0) v = W[(size_t)(k0 + kk) * Nsrc + src]; tv[s][i] = v; } }
    f32x4 ks0 = {1.f, 1.f, 1.f, 1.f}, ks1 = ks0; if (SC) { ks0 = *(const f32x4*)(kscale + k0 + 8 * (lane & 7)); ks1 = *(const f32x4*)(kscale + k0 + 8 * (lane & 7) + 4); }
#pragma unroll
    for (int s = 0; s < 2; ++s) {
#pragma unroll
        for (int i = 0; i < 32; ++i) { const int kk = 2 * i + (lane >> 5); scr[kk * 33 + (lane & 31)] = tv[s][i]; }
        LDS_WAIT(); asm volatile("" ::: "memory");
        const int c = lane & 7;
#pragma unroll
        for (int j = 0; j < 4; ++j) { const int nn = (lane >> 3) + 8 * j; const LAS float* sp = scr + (8 * c) * 33 + nn;
            u32x4 o; if (SC) { o.x = pk2(sp[0 * 33] * ks0[0], sp[1 * 33] * ks0[1]); o.y = pk2(sp[2 * 33] * ks0[2], sp[3 * 33] * ks0[3]); o.z = pk2(sp[4 * 33] * ks1[0], sp[5 * 33] * ks1[1]); o.w = pk2(sp[6 * 33] * ks1[2], sp[7 * 33] * ks1[3]); }
            else { o.x = pk2(sp[0 * 33], sp[1 * 33]); o.y = pk2(sp[2 * 33], sp[3 * 33]); o.z = pk2(sp[4 * 33], sp[5 * 33]); o.w = pk2(sp[6 * 33], sp[7 * 33]); }
            *(u32x4*)(WT + (size_t)(n0 + 32 * s + nn) * K + k0 + 8 * c) = o; }
        LDS_WAIT(); asm volatile("" ::: "memory"); }
}
__device__ __forceinline__ void phase_prep(const Ctx& X, LAS unsigned char* lds) {
    for (int it = blockIdx.x; it < 8 * 12; it += X.G) {
        const int ks8 = it / 12, jb = it - ks8 * 12, col = jb * 256 + (X.tid & 255), slice = ks8 * 2 + (X.tid >> 8);
        float a = 0.f; const float* const cp = INF(I_C); const float* const wa = INF(I_WADA);
#pragma unroll 1
        for (int k0 = slice * 64; k0 < slice * 64 + 64; k0 += 32) { float w[32];
#pragma unroll
            for (int k = 0; k < 32; ++k) w[k] = wa[(size_t)(k0 + k) * 3072 + col];
#pragma unroll
            for (int k = 0; k < 32; ++k) a += siluf_(cp[k0 + k]) * w[k]; }
        ((float*)(X.ws + WS_MODP))[slice * 3072 + col] = a;
    }
    if (blockIdx.x < 8 * 12) {
        VM_WAIT(); __syncthreads();
        if (X.tid == 0) { __builtin_amdgcn_fence(__ATOMIC_RELEASE, "agent"); asm volatile("s_waitcnt vmcnt(0)" ::: "memory");
            __hip_atomic_fetch_add((unsigned*)(X.ws + WS_CTL) + CW_GEMV, 1u, __ATOMIC_RELAXED, __HIP_MEMORY_SCOPE_AGENT); }
    }
    LAS float* scr = (LAS float*)(lds + X.wave * 16384);
    const int gw = X.vcu * NWAVES + X.wave, NGW = X.G * NWAVES;
    constexpr int I_IN = (NWIN / 64) * 16, I_Q = (1536 / 64) * 6, I_KV = (2048 / 64) * 4, I_PM = 16 * 16, I_PR = 16 * 32, I_O = 16 * 16;
    constexpr int NITEMS = I_IN + I_Q + I_KV + I_PM + I_PR + I_O;
    for (int it = gw; it < NITEMS; it += NGW) {
        int r = it;
        if (r < I_IN) { transpose_item<0, false>(INF(I_WIN), 1024, 9920, 16, nullptr, (bf16_t*)(X.ws + WS_WIN), scr, r, X.lane); continue; } r -= I_IN;
        if (r < I_Q) { transpose_item<1, true>(INF(I_WQUP), 384, 1536, 6, INF(I_GQ), (bf16_t*)(X.ws + WS_WQ), scr, r, X.lane); continue; } r -= I_Q;
        if (r < I_KV) { transpose_item<2, true>(INF(I_WKVUP), 256, 2048, 4, INF(I_GKV), (bf16_t*)(X.ws + WS_WKV), scr, r, X.lane); continue; } r -= I_KV;
        if (r < I_PM) { transpose_item<2, false>(INF(I_WPM), 1024, 1024, 16, nullptr, (bf16_t*)(X.ws + WS_WPM), scr, r, X.lane); continue; } r -= I_PM;
        if (r < I_PR) { transpose_item<2, false>(INF(I_WPR), 2048, 1024, 32, nullptr, (bf16_t*)(X.ws + WS_WPR), scr, r, X.lane); continue; } r -= I_PR;
        transpose_item<2, false>(INF(I_WOUT), 1024, 1024, 16, nullptr, (bf16_t*)(X.ws + WS_WO), scr, r, X.lane);
    }
}
__device__ __forceinline__ void phase_h(const Ctx& X, LAS unsigned char* lds) {
    LAS float* modl = (LAS float*)lds;
    if (X.tid == 0) { unsigned sp = 0; const unsigned* cg = (const unsigned*)(X.ws + WS_CTL) + CW_GEMV;
        while (__hip_atomic_load(cg, __ATOMIC_RELAXED, __HIP_MEMORY_SCOPE_AGENT) < 96u) { __builtin_amdgcn_s_sleep(8); if (++sp > (1u << 22)) break; }
        __builtin_amdgcn_fence(__ATOMIC_ACQUIRE, "agent"); asm volatile("s_waitcnt vmcnt(0)" ::: "memory"); }
    __syncthreads();
    const float* const badap = INF(I_BADA); const float* const gprep = INF(I_GPRE); const float* const xp = INF(I_X);
    { float pv[4][16], bv[4];
#pragma unroll
      for (int q = 0; q < 4; ++q) { const float* mp = (const float*)(X.ws + WS_MODP) + X.tid + 512 * q; bv[q] = badap[X.tid + 512 * q];
#pragma unroll
          for (int s = 0; s < 16; ++s) pv[q][s] = mp[s * 3072]; }
#pragma unroll
      for (int q = 0; q < 4; ++q) { const int j = X.tid + 512 * q; float a = bv[q];
#pragma unroll
          for (int s = 0; s < 16; ++s) a += pv[q][s];
          modl[j] = a; if (blockIdx.x == 0) ((float*)(X.ws + WS_MOD))[j] = a; } }
    if (blockIdx.x == 0) {
        float pv[2][16], bv[2];
#pragma unroll
        for (int q = 0; q < 2; ++q) { const float* mp = (const float*)(X.ws + WS_MODP) + 2048 + X.tid + 512 * q; bv[q] = badap[2048 + X.tid + 512 * q];
#pragma unroll
            for (int s = 0; s < 16; ++s) pv[q][s] = mp[s * 3072]; }
#pragma unroll
        for (int q = 0; q < 2; ++q) { float a = bv[q];
#pragma unroll
            for (int s = 0; s < 16; ++s) a += pv[q][s];
            ((float*)(X.ws + WS_MOD))[2048 + X.tid + 512 * q] = a; } }
    __syncthreads();
    f32x4 ca[4], cb[4];
#pragma unroll
    for (int j = 0; j < 4; ++j) { const int col = 256 * j + 4 * X.lane;
#pragma unroll
        for (int q = 0; q < 4; ++q) { ca[j][q] = gprep[col + q] * (1.0f + modl[1024 + col + q]); cb[j][q] = modl[col + q]; } }
    const int gw = X.vcu * NWAVES + X.wave, NGW = X.G * NWAVES;
    {
        f32x4 v[8][4];
#pragma unroll
        for (int r = 0; r < 8; ++r) { const f32x4* xr = (const f32x4*)(xp + (size_t)(gw + r * NGW) * DM) + X.lane;
#pragma unroll
            for (int j = 0; j < 4; ++j) v[r][j] = xr[64 * j]; }
#pragma unroll
        for (int r = 0; r < 8; ++r) { float s2 = 0.f;
#pragma unroll
            for (int j = 0; j < 4; ++j) s2 += (v[r][j][0] * v[r][j][0] + v[r][j][1] * v[r][j][1]) + (v[r][j][2] * v[r][j][2] + v[r][j][3] * v[r][j][3]);
            const float rstd = __builtin_amdgcn_rsqf(wave_sum(s2) * (1.0f / DM) + EPS);
            u32x2* o8 = (u32x2*)((bf16_t*)(X.ws + WS_H) + (size_t)(gw + r * NGW) * DM) + X.lane;
#pragma unroll
            for (int j = 0; j < 4; ++j) { const f32x4 y = v[r][j] * rstd * ca[j] + cb[j]; u32x2 w; w.x = pk2(y[0], y[1]); w.y = pk2(y[2], y[3]); o8[64 * j] = w; } }
    }
    __syncthreads();
}
__device__ __forceinline__ void phase_scan(const Ctx& X) {
    const int gt = blockIdx.x * NTHR + X.tid;
    const int h = gt >> 15, e = (gt >> 7) & 255, d2 = gt & 127; const float g = fast_exp2(256.0f * l2gamma(h));
    unsigned* p = (unsigned*)((bf16_t*)(X.ws + WS_VRH) + ((size_t)(h * 64) * 256 + e) * 512 + 256 + 2 * d2);
    float r0 = 0.f, r1 = 0.f;
#pragma unroll 1
    for (int c0 = 0; c0 < 64; c0 += 32) {
        unsigned u[32];
#pragma unroll
        for (int c = 0; c < 32; ++c) u[c] = p[(size_t)(c0 + c) * 65536];
#pragma unroll
        for (int c = 0; c < 32; ++c) { p[(size_t)(c0 + c) * 65536] = cvt_pk_bf16(r0, r1); r0 = g * r0 + bflo(u[c]); r1 = g * r1 + bfhi(u[c]); }
    }
}
__device__ __forceinline__ void phase_norm(const Ctx& X) {
    const int gw = X.vcu * NWAVES + X.wave, NGW = X.G * NWAVES; const float* fsq = (const float*)(X.ws + WS_FSQ);
    f32x4 gf[4];
#pragma unroll
    for (int j = 0; j < 4; ++j) gf[j] = *((const f32x4*)INF(I_GFINAL) + 64 * j + X.lane);
    for (int m0 = gw; m0 < SEQ; m0 += 4 * NGW) {
        f32x4 v[4][4], q[4][4];
#pragma unroll
        for (int r = 0; r < 4; ++r) { const int m = m0 + r * NGW; const f32x4* sp = (const f32x4*)(fsq + (size_t)m * 16); const f32x4* xr = (const f32x4*)(X.out + (size_t)m * DM) + X.lane;
#pragma unroll
            for (int j = 0; j < 4; ++j) { q[r][j] = sp[j]; v[r][j] = xr[64 * j]; } }
#pragma unroll
        for (int r = 0; r < 4; ++r) { const int m = m0 + r * NGW; float ss = 0.f;
#pragma unroll
            for (int j = 0; j < 4; ++j) ss += (q[r][j][0] + q[r][j][1]) + (q[r][j][2] + q[r][j][3]);
            const float rstd = 1.0f / sqrtf(ss * (1.0f / DM) + EPS);
            f32x4* xr = (f32x4*)(X.out + (size_t)m * DM) + X.lane;
#pragma unroll
            for (int j = 0; j < 4; ++j) xr[64 * j] = v[r][j] * rstd * gf[j]; }
    }
}

enum Op { OP_PREP = 0, OP_H, OP_GEMM, OP_SCAN, OP_ATTN, OP_NORM };
enum Sync { SY_NONE = 0, SY_LOCAL, SY_GRID, SY_PANEL, SY_AFLAG, SY_WAR };
struct Step { int op, sync; GCall g; };
__device__ const Step STEPS[] = {
    {OP_PREP, SY_NONE, {0, 0, 0, 0, 0, 0, 0}},
    {OP_H,    SY_GRID, {0, 0, 0, 0, 0, 0, 0}},
    {OP_GEMM, SY_NONE,  {K_QK,    8, 1024, 1024, 1024, 0, 0}},
    {OP_GEMM, SY_NONE,  {K_TRANS, 4, 1024, 1024, 1024, 0, 0}},
    {OP_GEMM, SY_LOCAL, {K_LOW,   3, 1024, 1024, 1024, 0, 0}},
    {OP_GEMM, SY_NONE,  {K_S,     4, 256,  512,  256,  0, 0}},
    {OP_GEMM, SY_GRID,  {K_U,     4, 256,  512,  256,  0, 0}},
    {OP_SCAN, SY_GRID,  {0, 0, 0, 0, 0, 0, 0}},
    {OP_GEMM, SY_NONE,  {K_MAIN,  4, 512,  512,  512,  0, 0}},
    {OP_GEMM, SY_LOCAL, {K_TRANS, 4, 1024, 1024, 1024, 1, 0}},
    {OP_GEMM, SY_GRID,  {K_U,     4, 256,  512,  256,  1, 0}},
    {OP_SCAN, SY_GRID,  {0, 0, 0, 0, 0, 0, 0}},
    {OP_GEMM, SY_NONE,  {K_MAIN,  4, 512,  512,  512,  1, 0}},
    {OP_GEMM, SY_WAR,   {K_GRET,  8, 1024, 1024, 1024, 0, 0}},
    {OP_GEMM, SY_NONE,  {K_QUP,   6, 384,  384,  384,  0, 0}},
    {OP_GEMM, SY_GRID,  {K_KVUP,  8, 256,  256,  256,  0, 0}},
    {OP_ATTN, SY_AFLAG, {0, 0, 0, 0, 0, 0, 0}},
    {OP_GEMM, SY_NONE,  {K_GMLA,  4, 1024, 1024, 1024, 0, 0}},
    {OP_GEMM, SY_PANEL, {K_P0,    4, 1024, 1024, 1024, 0, 1}},
    {OP_GEMM, SY_NONE,  {K_P1,    4, 1024, 1024, 1024, 0, 0}},
    {OP_GEMM, SY_NONE,  {K_P2,    4, 1024, 1024, 1024, 0, 0}},
    {OP_GEMM, SY_PANEL, {K_P3,    4, 2048, 2048, 2048, 0, 2}},
    {OP_GEMM, SY_NONE,  {K_FINAL, 4, 1024, 1024, 1024, 0, 0}} };
constexpr int NSTEPS = 23;
__device__ __forceinline__ GCall step_call(int si) { return STEPS[si].g; }

constexpr int NPHASES = NSTEPS;
struct Args { const void* in[16]; float* out; unsigned char* ws; int ph_lo, ph_hi; };
__global__ void __launch_bounds__(NTHR, 2) fwd_kernel(Args args) {
    extern __shared__ __attribute__((aligned(16))) unsigned char lds_raw[];
    LAS unsigned char* lds = (LAS unsigned char*)lds_raw;
    Ctx X; X.out = args.out; X.ws = args.ws;
    X.tid = threadIdx.x; X.lane = X.tid & 63; X.wave = __builtin_amdgcn_readfirstlane(X.tid >> 6);
    X.G = gridDim.x; { const int bx = blockIdx.x; X.vcu = (bx % 8) * (X.G / 8) + bx / 8; }
    volatile LAS unsigned* MISC = (volatile LAS unsigned*)(lds + MISC_OFF);
    for (int u = X.tid; u < (LDS_BYTES - LDSCTL_OFF) / 4; u += NTHR) ((LAS unsigned*)(lds + LDSCTL_OFF))[u] = 0u;
    __syncthreads();
    if (X.tid < 16) *(LAS unsigned long long*)(lds + PTR_OFF + 8 * X.tid) = (unsigned long long)args.in[X.tid];
    if (X.tid == 16) *(LAS unsigned long long*)(lds + PTR_OFF + 8 * 16) = (unsigned long long)args.out;
    if (X.tid == 17) *(LAS unsigned long long*)(lds + PTR_OFF + 8 * 17) = (unsigned long long)args.ws;
    __syncthreads();
    gu32* ctl = (gu32*)(X.ws + WS_CTL);
    XcdBarrier bar = xcd_barrier_post((unsigned*)(ctl + CW_BAR), MISC + 8);
    const int lo = args.ph_lo, hi = args.ph_hi;
    const Ctx X_ = X;
    for (int si = lo; si < hi; ++si) {
        Ctx X = X_; asm volatile("" : "+v"(X.tid), "+v"(X.lane), "+s"(X.wave), "+s"(X.vcu)); X.out = (float*)inptr_raw(16); X.ws = (unsigned char*)inptr_raw(17);
        const int op = STEPS[si].op, sync = STEPS[si].sync;
        if (op == OP_PREP) phase_prep(X, lds);
        else if (op == OP_H) phase_h(X, lds);
        else if (op == OP_SCAN) phase_scan(X);
        else if (op == OP_ATTN) {
            const int head = X.vcu >> 5, l = X.vcu & 31;
            const bf16_t* Qh = (const bf16_t*)(X.ws + WS_Q) + head * 192; const bf16_t* Kh = (const bf16_t*)(X.ws + WS_K) + head * 192; const bf16_t* Vh = (const bf16_t*)(X.ws + WS_V) + head * 128;
            bf16_t* Oh = (bf16_t*)(X.ws + WS_O) + head * 128;
#pragma unroll 1
            for (int pass = 0; pass < 2; ++pass) att16::attn_unit(Qh, Kh, Vh, Oh, 256 * (pass ? 63 - l : l), (char*)lds_raw, X.tid);
        }
        else if (op == OP_NORM) phase_norm(X);
        int sync_ = sync;
        if (op == OP_GEMM) { int ns = 1; while (si + ns < hi && STEPS[si + ns - 1].sync == SY_NONE && STEPS[si + ns].op == OP_GEMM) ++ns;
            gemm_stream(lds, si, ns, X); si += ns - 1; sync_ = STEPS[si].sync; }
        if (si + 1 < hi) {
            if (sync_ == SY_GRID) { xcd_barrier(bar);
            }
            else if (sync_ == SY_PANEL) {
                VM_WAIT(); __syncthreads();
                if (X.tid == 0) { unsigned* cp = (unsigned*)(X.ws + WS_CTL) + CW_PANEL + 64 * (8 * (X.vcu >> 5) + (X.vcu & 7));
                    __builtin_amdgcn_fence(__ATOMIC_RELEASE, "agent"); asm volatile("s_waitcnt vmcnt(0)" ::: "memory");
                    __hip_atomic_fetch_add(cp, 1u, __ATOMIC_RELAXED, __HIP_MEMORY_SCOPE_AGENT);
                    const unsigned panel_need = 4u * (unsigned)STEPS[si].g.nk;
                    unsigned sp = 0; while (__hip_atomic_load(cp, __ATOMIC_RELAXED, __HIP_MEMORY_SCOPE_AGENT) < panel_need) { __builtin_amdgcn_s_sleep(4); if (++sp > (1u << 22)) break; }
                    __builtin_amdgcn_fence(__ATOMIC_ACQUIRE, "agent"); asm volatile("s_waitcnt vmcnt(0)" ::: "memory"); }
                __syncthreads(); }
            else if (sync_ == SY_AFLAG) {
                VM_WAIT(); __syncthreads();
                if (X.tid == 0) { unsigned* fl = (unsigned*)(X.ws + WS_CTL) + CW_AFLAG; const int l_ = X.vcu & 31;
                    __builtin_amdgcn_fence(__ATOMIC_RELEASE, "agent"); asm volatile("s_waitcnt vmcnt(0)" ::: "memory");
                    __hip_atomic_fetch_add((unsigned*)(X.ws + WS_CTL) + CW_ADONE, 1u, __ATOMIC_RELAXED, __HIP_MEMORY_SCOPE_AGENT);
                    __hip_atomic_store(fl + (X.vcu >> 5) * 64 + l_, 1u, __ATOMIC_RELAXED, __HIP_MEMORY_SCOPE_AGENT); __hip_atomic_store(fl + (X.vcu >> 5) * 64 + 63 - l_, 1u, __ATOMIC_RELAXED, __HIP_MEMORY_SCOPE_AGENT);
                    const int t_ = 8 * (X.vcu >> 5) + (X.vcu & 7), o_ = (X.vcu & 31) >> 3; const unsigned* f0 = fl + (2 * o_) * 64 + t_;
                    unsigned sp = 0; while ((__hip_atomic_load(f0, __ATOMIC_RELAXED, __HIP_MEMORY_SCOPE_AGENT) & __hip_atomic_load(f0 + 64, __ATOMIC_RELAXED, __HIP_MEMORY_SCOPE_AGENT)) == 0u) { __builtin_amdgcn_s_sleep(4); if (++sp > (1u << 22)) break; }
                    __builtin_amdgcn_fence(__ATOMIC_ACQUIRE, "agent"); asm volatile("s_waitcnt vmcnt(0)" ::: "memory"); }
                __syncthreads(); }
            else if (sync_ == SY_WAR) {
                VM_WAIT(); __syncthreads();
                if (X.tid == 0) { const unsigned* cw = (const unsigned*)(X.ws + WS_CTL) + CW_WAR;
                    unsigned sp = 0; while (__hip_atomic_load(cw, __ATOMIC_RELAXED, __HIP_MEMORY_SCOPE_AGENT) < (unsigned)X.G) { __builtin_amdgcn_s_sleep(4); if (++sp > (1u << 22)) break; }
                    __builtin_amdgcn_fence(__ATOMIC_ACQUIRE, "agent"); asm volatile("s_waitcnt vmcnt(0)" ::: "memory"); }
                __syncthreads(); }
            else if (sync_ == SY_LOCAL) { VM_WAIT(); __syncthreads(); if (X.tid == 0) { __builtin_amdgcn_fence(__ATOMIC_ACQUIRE, "agent"); } VM_WAIT(); __syncthreads(); }
        }
    }
}


extern "C" void kernel_launch(void* const* d_in, const int* in_sizes, int n_in, void* d_out, int out_size, void* d_ws, size_t ws_size, hipStream_t stream) {
    static int grid = 0;
    if (grid == 0) {
        if (n_in != 16 || out_size != SEQ * DM || ws_size < WS_END) { fprintf(stderr, "kernel_launch: unexpected shapes (n_in %d out %d ws %zu)\n", n_in, out_size, ws_size); grid = -1; return; }
        int dev = 0, cus = 0;
        if (hipGetDevice(&dev) != hipSuccess || hipDeviceGetAttribute(&cus, hipDeviceAttributeMultiprocessorCount, dev) != hipSuccess) { grid = -1; return; }
        if (hipFuncSetAttribute((const void*)fwd_kernel, hipFuncAttributeMaxDynamicSharedMemorySize, LDS_BYTES) != hipSuccess) { fprintf(stderr, "kernel_launch: hipFuncSetAttribute failed\n"); grid = -1; return; }
        (void)hipGetLastError();
        grid = cus;
        if (grid != 256) { fprintf(stderr, "kernel_launch: built for 256 CUs, found %d\n", cus); grid = -1; return; }
    }
    if (grid < 0) return;
    (void)in_sizes;
    if (hipMemsetAsync((char*)d_ws + WS_CTL, 0, CTL_ZERO_BYTES, stream) != hipSuccess) return;
    Args a{};
    for (int i = 0; i < 16; ++i) a.in[i] = d_in[i];
    a.out = (float*)d_out; a.ws = (unsigned char*)d_ws; a.ph_lo = 0; a.ph_hi = NPHASES;
    hipLaunchKernelGGL(fwd_kernel, dim3(grid), dim3(NTHR), LDS_BYTES, stream, a);
}
```

```cpp
#include <hip/hip_runtime.h>
#include <cstdio>
#include <cstdint>

#define GAS __attribute__((address_space(1)))
#define LAS __attribute__((address_space(3)))
typedef unsigned short bf16_t;
typedef short bf16x8 __attribute__((ext_vector_type(8)));
typedef short s16x4 __attribute__((ext_vector_type(4)));
typedef float f32x4 __attribute__((ext_vector_type(4)));
typedef float f32x2 __attribute__((ext_vector_type(2)));
typedef float f32x16 __attribute__((ext_vector_type(16)));
typedef unsigned u32x4 __attribute__((ext_vector_type(4)));
typedef unsigned u32x2 __attribute__((ext_vector_type(2)));
typedef GAS unsigned gu32;

constexpr int SEQ = 16384, DM = 1024;
constexpr int NWAVES = 8, NTHR = 512;
constexpr float EPS = 1e-6f;
constexpr int NWIN = 9984;
constexpr int WT_QRET = 0, WT_KRET = 4, WT_VRET = 8, WT_GRET = 16, WT_GMLA = 24, WT_MMLA = 28, WT_MRET = 32, WT_LOW = 36;

constexpr size_t MiB = 1u << 20;
constexpr size_t WS_CTL = 0, CTL_ZERO_BYTES = 64 * 1024;
constexpr size_t WS_MODP = 128 * 1024;
constexpr size_t WS_MOD = 512 * 1024;
constexpr size_t WS_FSQ = 1 * MiB;
constexpr size_t WS_PSQ = 2 * MiB;
constexpr size_t WS_STAT = 4 * MiB;
constexpr size_t WS_WIN = 8 * MiB;
constexpr size_t WS_WQ = 28 * MiB;
constexpr size_t WS_WKV = 30 * MiB;
constexpr size_t WS_WPM = 31 * MiB;
constexpr size_t WS_WPR = 33 * MiB;
constexpr size_t WS_WO = 37 * MiB;
constexpr size_t WS_H = 40 * MiB;
constexpr size_t WS_X = 72 * MiB;
constexpr size_t WS_AQ = WS_X;
constexpr size_t WS_VRH = WS_X + 64 * MiB;
constexpr size_t WS_KZT = WS_X + 128 * MiB;
constexpr size_t WS_CQ = WS_X + 160 * MiB;
constexpr size_t WS_CKV = WS_X + 172 * MiB;
constexpr size_t WS_KROPE = WS_X + 180 * MiB;
constexpr size_t WS_Q = WS_X + 24 * MiB;
constexpr size_t WS_K = WS_X + 72 * MiB;
constexpr size_t WS_V = WS_X + 120 * MiB;
constexpr size_t WS_O = WS_X + 152 * MiB;
constexpr size_t WS_SCRA = WS_X;
constexpr size_t WS_SCRB = WS_X + 32 * MiB;
constexpr size_t WS_SCRA2 = WS_X + 64 * MiB;
constexpr size_t WS_MERGED = WS_X + 96 * MiB;
constexpr size_t WS_END = 256 * MiB;

constexpr int CW_BAR = 4096;
constexpr int CW_CNT = 8192;
constexpr int CW_PANEL = 12288;
constexpr int CW_ADONE = 2816;
constexpr int CW_WAR = 2560;
constexpr int CW_XCC = 512;
constexpr int CW_GEMV = 2048;
constexpr int CW_AFLAG = 3072;

constexpr int RING_BYTES = 131072;
constexpr int LDSCTL_OFF = RING_BYTES, MISC_OFF = LDSCTL_OFF + 320;
constexpr int LDS_BYTES = 147456;

#define RLX_AGENT __ATOMIC_RELAXED, __HIP_MEMORY_SCOPE_AGENT
#define LDS_WAIT() asm volatile("s_waitcnt lgkmcnt(0)" ::: "memory")
#define VM_WAIT() asm volatile("s_waitcnt vmcnt(0)" ::: "memory")
__device__ __forceinline__ unsigned f2bf(float f) { unsigned u = __builtin_bit_cast(unsigned, f); return (u + 0x7fffu + ((u >> 16) & 1u)) >> 16; }
__device__ __forceinline__ unsigned pk2(float lo, float hi) { return f2bf(lo) | (f2bf(hi) << 16); }
__device__ __forceinline__ float bf2f(unsigned short b) { return __builtin_bit_cast(float, ((unsigned)b) << 16); }
__device__ __forceinline__ float bflo(unsigned w) { return __builtin_bit_cast(float, w << 16); }
__device__ __forceinline__ float bfhi(unsigned w) { return __builtin_bit_cast(float, w & 0xffff0000u); }
typedef __bf16 bf16x2_t __attribute__((ext_vector_type(2)));
__device__ __forceinline__ unsigned cvt_pk_bf16(float lo, float hi) { f32x2 v = {lo, hi}; bf16x2_t b = __builtin_convertvector(v, bf16x2_t); return __builtin_bit_cast(unsigned, b); }
__device__ __forceinline__ float fast_exp2(float x) { return __builtin_amdgcn_exp2f(x); }
__device__ __forceinline__ float fast_rcp(float x) { return __builtin_amdgcn_rcpf(x); }
__device__ __forceinline__ float sigmoidf_(float x) { return fast_rcp(1.0f + fast_exp2(-1.4426950408889634f * x)); }
__device__ __forceinline__ float siluf_(float x) { return x * sigmoidf_(x); }
__device__ __forceinline__ void sincos_ang(float ang, float& s, float& c) {
    const float hi = 0.15915493667125702f, lo = 6.420638326565253e-09f;
    const float p = ang * hi; float e = __builtin_fmaf(ang, hi, -p); e = __builtin_fmaf(ang, lo, e);
    const float f = (p - __builtin_rintf(p)) + e;
    s = __builtin_amdgcn_sinf(f); c = __builtin_amdgcn_cosf(f);
}
__device__ __forceinline__ float wave_sum(float v) {
#pragma unroll
    for (int o = 1; o < 64; o <<= 1) v += __shfl_xor(v, o);
    return v;
}
__device__ const float INVF[128] = { 1.000000000e+00f, 9.305720329e-01f, 8.659643531e-01f, 8.058421612e-01f, 7.498942018e-01f, 6.978305578e-01f, 6.493816376e-01f, 6.042963862e-01f, 5.623413324e-01f, 5.232990980e-01f, 4.869675338e-01f, 4.531583786e-01f, 4.216965139e-01f, 3.924189806e-01f, 3.651741147e-01f, 3.398208320e-01f, 3.162277639e-01f, 2.942727208e-01f, 2.738419771e-01f, 2.548296750e-01f, 2.371373773e-01f, 2.206734121e-01f, 2.053525001e-01f, 1.910952926e-01f, 1.778279394e-01f, 1.654817164e-01f, 1.539926529e-01f, 1.433012635e-01f, 1.333521456e-01f, 1.240937784e-01f, 1.154781953e-01f, 1.074607819e-01f, 1.000000015e-01f, 9.305720776e-02f, 8.659642935e-02f, 8.058422059e-02f, 7.498942316e-02f, 6.978306174e-02f, 6.493816525e-02f, 6.042964011e-02f, 5.623413250e-02f, 5.232991278e-02f, 4.869675264e-02f, 4.531583562e-02f, 4.216964915e-02f, 3.924189880e-02f, 3.651741147e-02f, 3.398208320e-02f, 3.162277490e-02f, 2.942727134e-02f, 2.738419548e-02f, 2.548296750e-02f, 2.371373773e-02f, 2.206734009e-02f, 2.053525113e-02f, 1.910953037e-02f, 1.778279431e-02f, 1.654817164e-02f, 1.539926510e-02f, 1.433012541e-02f, 1.333521400e-02f, 1.240937784e-02f, 1.154781971e-02f, 1.074607857e-02f, 9.999999776e-03f, 9.305720218e-03f, 8.659643121e-03f, 8.058422245e-03f, 7.498942316e-03f, 6.978305988e-03f, 6.493816152e-03f, 6.042963825e-03f, 5.623413250e-03f, 5.232991185e-03f, 4.869675264e-03f, 4.531583749e-03f, 4.216964822e-03f, 3.924189601e-03f, 3.651741194e-03f, 3.398208413e-03f, 3.162277630e-03f, 2.942727180e-03f, 2.738419687e-03f, 2.548296703e-03f, 2.371373819e-03f, 2.206734149e-03f, 2.053525066e-03f, 1.910952968e-03f, 1.778279431e-03f, 1.654817141e-03f, 1.539926510e-03f, 1.433012541e-03f, 1.333521446e-03f, 1.240937738e-03f, 1.154782018e-03f, 1.074607833e-03f, 1.000000047e-03f, 9.305720450e-04f, 8.659643354e-04f, 8.058421663e-04f, 7.498941850e-04f, 6.978305755e-04f, 6.493816036e-04f, 6.042963942e-04f, 5.623413017e-04f, 5.232990952e-04f, 4.869675322e-04f, 4.531583691e-04f, 4.216965172e-04f, 3.924189659e-04f, 3.651741135e-04f, 3.398208355e-04f, 3.162277571e-04f, 2.942727297e-04f, 2.738419571e-04f, 2.548296761e-04f, 2.371373703e-04f, 2.206734061e-04f, 2.053525095e-04f, 1.910952997e-04f, 1.778279402e-04f, 1.654817170e-04f, 1.539926598e-04f, 1.433012512e-04f, 1.333521504e-04f, 1.240937709e-04f, 1.154782003e-04f, 1.074607862e-04f };
__device__ __forceinline__ float l2gamma(int h) { return h == 0 ? -0.04580368961312479f : h == 1 ? -0.02272007650008353f : h == 2 ? -0.011315313227834146f : -0.005646563141142063f; }

#define XB_TMO      128
#define XB_XCNT(j)  (256  + 64 * (j))
#define XB_XSUB(j)  (1280 + 64 * (j))
#define XB_XGEN(j)  (2304 + 64 * (j))
#define XB_TOP      3328
#define XB_TOPGEN   3392
#define XCD_BAR_WORDS 3456
#define XB_SPIN_CAP (1u << 18)
__device__ __forceinline__ unsigned xb_ld(unsigned* p)              { return __hip_atomic_load(p, __ATOMIC_RELAXED, __HIP_MEMORY_SCOPE_AGENT); }
__device__ __forceinline__ unsigned xb_add(unsigned* p, unsigned v) { return __hip_atomic_fetch_add(p, v, __ATOMIC_RELAXED, __HIP_MEMORY_SCOPE_AGENT); }
__device__ __forceinline__ unsigned xb_xcc_id() { return (unsigned)__builtin_amdgcn_s_getreg((3 << 11) | 20) & 0xFu; }
#define XB_SPIN(cond, bar) do { unsigned _sp = 0; while (cond) { __builtin_amdgcn_s_sleep(1); \
    if ((++_sp & 255u) == 0u) { if (xb_ld(&(bar)[XB_TMO])) break; if (_sp > XB_SPIN_CAP) { atomicAdd(&(bar)[XB_TMO], 1u); break; } } } } while (0)
struct XcdBarrier { unsigned* bar; unsigned x; volatile LAS unsigned* st; };
__device__ __forceinline__ XcdBarrier xcd_barrier_post(unsigned* bar, volatile LAS unsigned* st) {
    XcdBarrier b; b.bar = bar; b.x = xb_xcc_id(); b.st = st;
    if (threadIdx.x == 0) (void)xb_add(&bar[XB_XCNT(b.x)], 1u);
    return b;
}
__device__ __forceinline__ void xcd_barrier_complete(unsigned* bar, unsigned x, unsigned& nloc, unsigned& nx) {
    const unsigned G = gridDim.x * gridDim.y * gridDim.z;
    unsigned sum, cnt, mine, sp = 0u;
    for (;;) {
        sum = 0u; cnt = 0u; mine = 0u;
#pragma unroll
        for (unsigned j = 0; j < 16; ++j) { const unsigned c = xb_ld(&bar[XB_XCNT(j)]); sum += c; cnt += (c > 0u) ? 1u : 0u; mine = (j == x) ? c : mine; }
        if (sum == G) break;
        __builtin_amdgcn_s_sleep(1);
        if ((++sp & 255u) == 0u) { if (xb_ld(&bar[XB_TMO])) break; if (sp > XB_SPIN_CAP) { atomicAdd(&bar[XB_TMO], 1u); break; } }
    }
    nloc = mine > 0u ? mine : 1u; nx = cnt > 0u ? cnt : 1u;
}
__device__ __forceinline__ void xcd_barrier(const XcdBarrier& b) {
    asm volatile("s_waitcnt vmcnt(0)" ::: "memory");
    __syncthreads();
    if (threadIdx.x == 0) {
        unsigned* bar = b.bar;
        __builtin_amdgcn_s_waitcnt(0);
        unsigned nloc = b.st[0], nx = b.st[1];
        if (nloc == 0u) { xcd_barrier_complete(bar, b.x, nloc, nx); b.st[0] = nloc; b.st[1] = nx; }
        const unsigned old = xb_add(&bar[XB_XSUB(b.x)], 1u);
        const unsigned gen = old / nloc;
        if (old + 1u == (gen + 1u) * nloc) {
            __builtin_amdgcn_fence(__ATOMIC_RELEASE, "agent");
            asm volatile("s_waitcnt vmcnt(0)" ::: "memory");
            const unsigned og = xb_add(&bar[XB_TOP], 1u);
            const unsigned tg = og / nx;
            if (og + 1u == (tg + 1u) * nx) xb_add(&bar[XB_TOPGEN], 1u);
            else XB_SPIN(xb_ld(&bar[XB_TOPGEN]) == tg, bar);
            __builtin_amdgcn_fence(__ATOMIC_ACQUIRE, "agent");
            asm volatile("s_waitcnt vmcnt(0)" ::: "memory");
        } else {
            XB_SPIN(xb_ld(&bar[XB_TOPGEN]) == gen, bar);
            __builtin_amdgcn_fence(__ATOMIC_ACQUIRE, "agent");
            asm volatile("s_waitcnt vmcnt(0)" ::: "memory");
        }
    }
    __syncthreads();
}

struct Ctx {
    float* out; unsigned char* ws;
    int tid, lane, wave, vcu, G;
};
enum InIdx { I_X = 0, I_C, I_POS, I_WADA, I_BADA, I_GPRE, I_WIN, I_GQ, I_WQUP, I_GKV, I_WKVUP, I_GRET, I_WPM, I_WPR, I_WOUT, I_GFINAL };
constexpr int PTR_OFF = LDSCTL_OFF;
__device__ __forceinline__ const void* inptr_raw(int k) {
    const volatile LAS unsigned* p = (const volatile LAS unsigned*)(size_t)(PTR_OFF + 8 * k);
    const unsigned lo = (unsigned)__builtin_amdgcn_readfirstlane((int)p[0]), hi = (unsigned)__builtin_amdgcn_readfirstlane((int)p[1]);
    return (const void*)(const GAS char*)(((unsigned long long)hi << 32) | lo);
}
#define INF(k) ((const float*)inptr_raw(k))
#define INI(k) ((const int*)inptr_raw(k))

enum Kind { K_QK = 0, K_TRANS, K_S, K_U, K_MAIN, K_LOW, K_QUP, K_KVUP, K_GMLA, K_GRET, K_P0, K_P1, K_P2, K_P3, K_FINAL };
struct GCall { int kind, NO, K, lda, ldb, hf, nk; };
struct Unit { int t, o; };
constexpr int BK = 64, HALF = 128, HTB = HALF * BK * 2;
constexpr float QSCALE = 0.07216878364870322f * 1.4426950408889634f;

__host__ __device__ __forceinline__ int lds_byte(int r, int c) { const int st = (r >> 4) * 2 + (c >> 5), rr = r & 15, cc = c & 31, ob = rr * 64 + cc * 2; return st * 1024 + (ob ^ (((ob >> 9) & 1) << 5)); }
__host__ __device__ __forceinline__ void stage_rc(int b, int& R, int& C) { const int st = b / 1024, sb = b % 1024, swz = sb ^ (((sb >> 9) & 1) << 5); R = (st >> 1) * 16 + swz / 64; C = (st & 1) * 32 + (swz % 64) / 2; }
__host__ __device__ __forceinline__ int perm32(int rho) { const int n = rho >> 4, i = rho & 15; return 8 * (i >> 2) + 4 * n + (i & 3); }

__device__ __forceinline__ bool unit_next(const GCall& g, int vcu, int i, Unit& u) {
    const int x = vcu >> 5, l = vcu & 31; u.t = 8 * x + (l & 7);
    if (g.kind == K_GRET) { u.o = 2 * (l >> 3) + i; return i < 2; }
    if (g.kind == K_KVUP) { const int q4 = l >> 3; if (q4 < 2) { u.o = q4; return i < 1; } u.o = q4 + 2 * i; return i < 3; }
    u.o = 4 * i + (l >> 3); return u.o < g.NO;
}
__device__ __forceinline__ void unit_ptrs(const GCall& g, const Ctx& X, const Unit& u, const char*& A, const char*& B) {
    size_t z_ = 0; asm volatile("" : "+s"(z_)); const unsigned char* wsb = X.ws + z_; const float* outb = X.out + z_;
    const bf16_t* a = nullptr; const bf16_t* b = nullptr;
    const bf16_t* Hb = (const bf16_t*)(wsb + WS_H); const bf16_t* Win = (const bf16_t*)(wsb + WS_WIN);
    const size_t t = (size_t)u.t, o = (size_t)u.o;
    switch (g.kind) {
    case K_QK:    a = Hb + t * 256 * 1024; b = Win + o * 256 * 1024; break;
    case K_TRANS: { const size_t rt = (u.o < g.nk) ? (size_t)(WT_KRET + u.o) : (size_t)(WT_VRET + (u.o - g.nk) * 2 + g.hf); a = Win + rt * 256 * 1024; b = Hb + t * 256 * 1024; } break;
    case K_S:     a = (const bf16_t*)(wsb + WS_AQ) + (o * SEQ + t * 256) * 512 + 256; b = (const bf16_t*)outb + (o * SEQ + t * 256) * 256; break;
    case K_U:     a = (const bf16_t*)(wsb + WS_VRH) + ((o * 64 + t) * 256) * 512; b = (const bf16_t*)(wsb + WS_KZT) + ((o * 64 + t) * 256) * 256; break;
    case K_MAIN:  a = (const bf16_t*)(wsb + WS_AQ) + (o * SEQ + t * 256) * 512; b = (const bf16_t*)(wsb + WS_VRH) + ((o * 64 + t) * 256) * 512; break;
    case K_LOW:   a = Hb + t * 256 * 1024; b = Win + (WT_LOW + o) * 256 * 1024; break;
    case K_QUP:   a = (const bf16_t*)(wsb + WS_CQ) + t * 256 * 384; b = (const bf16_t*)(wsb + WS_WQ) + o * 256 * 384; break;
    case K_KVUP:  a = (const bf16_t*)(wsb + WS_CKV) + t * 256 * 256; b = (const bf16_t*)(wsb + WS_WKV) + o * 256 * 256; break;
    case K_GMLA:  a = Hb + t * 256 * 1024; b = Win + (WT_GMLA + o) * 256 * 1024; break;
    case K_GRET:  a = Hb + t * 256 * 1024; b = Win + (WT_GRET + o) * 256 * 1024; break;
    case K_P0:    a = Hb + t * 256 * 1024; b = Win + (WT_MMLA + o) * 256 * 1024; break;
    case K_P1:    a = (const bf16_t*)(wsb + WS_O) + t * 256 * 1024; b = (const bf16_t*)(wsb + WS_WPM) + o * 256 * 1024; break;
    case K_P2:    a = Hb + t * 256 * 1024; b = Win + (WT_MRET + o) * 256 * 1024; break;
    case K_P3:    a = (const bf16_t*)outb + t * 256 * 2048; b = (const bf16_t*)(wsb + WS_WPR) + o * 256 * 2048; break;
    default:      a = (const bf16_t*)(wsb + WS_MERGED) + t * 256 * 1024; b = (const bf16_t*)(wsb + WS_WO) + o * 256 * 1024; break;
    }
    A = (const char*)a; B = (const char*)b;
}

__device__ __forceinline__ u32x4 pack8f(const f32x4 a, const f32x4 b) { u32x4 w; w.x = cvt_pk_bf16(a[0], a[1]); w.y = cvt_pk_bf16(a[2], a[3]); w.z = cvt_pk_bf16(b[0], b[1]); w.w = cvt_pk_bf16(b[2], b[3]); return w; }
__device__ __forceinline__ void unpack8(const u32x4 w, f32x4& a, f32x4& b) { a[0] = bflo(w.x); a[1] = bfhi(w.x); a[2] = bflo(w.y); a[3] = bfhi(w.y); b[0] = bflo(w.z); b[1] = bfhi(w.z); b[2] = bflo(w.w); b[3] = bfhi(w.w); }

struct EpiP { int kind, hf, nk; };
#define PIN8(a) asm volatile("" : "+v"(a[0]), "+v"(a[1]), "+v"(a[2]), "+v"(a[3]), "+v"(a[4]), "+v"(a[5]), "+v"(a[6]), "+v"(a[7]))
__device__ __forceinline__ void epilogue(const GCall& g0, const Ctx& X0, f32x4 (&acc)[2][2][4][2], const Unit& u, int wr, int wc, int fr, int fq) {
    size_t z_ = 0; asm volatile("" : "+s"(z_));
    struct { unsigned char* ws; float* out; } X = {X0.ws + z_, X0.out + z_}; EpiP g = {g0.kind, g0.hf, g0.nk};
    asm volatile("" : "+s"(g.kind), "+s"(g.hf), "+s"(g.nk), "+s"(wr), "+s"(wc), "+v"(fr), "+v"(fq));
    const int t = u.t, o = u.o;
    const int* const posp = INI(I_POS);
    const int cl0 = 32 * wc + 8 * fq;
    const int rl0 = 64 * wr + fr;
    switch (g.kind) {
    case K_QK: {
        const int h = o & 3; const bool isk = o >= 4; const float l2g = l2gamma(h);
        float invf[8];
#pragma unroll
        for (int j = 0; j < 8; ++j) invf[j] = INVF[cl0 + j];
        PIN8(invf);
        bf16_t* dst = isk ? ((bf16_t*)X.out + (size_t)h * SEQ * 256) : ((bf16_t*)(X.ws + WS_AQ) + (size_t)h * SEQ * 512 + 256);
        const int pitch = isk ? 256 : 512;
        int posv[2][4];
#pragma unroll
        for (int ai = 0; ai < 2; ++ai)
#pragma unroll
            for (int m = 0; m < 4; ++m) posv[ai][m] = posp[256 * t + 128 * ai + 16 * m + rl0];
#pragma unroll
        for (int ai = 0; ai < 2; ++ai)
#pragma unroll
            for (int m = 0; m < 4; ++m) {
                const int rl = 128 * ai + 16 * m + rl0, tok = 256 * t + rl;
                const float posf = (float)posv[ai][m];
                const float sc = isk ? 0.0625f * fast_exp2((float)(255 - rl) * l2g) : 1.0f;
                f32x4 o1[2], o2[2];
#pragma unroll
                for (int n = 0; n < 2; ++n)
#pragma unroll
                    for (int j = 0; j < 4; ++j) { float s, c; sincos_ang(posf * invf[4 * n + j], s, c); const float x1 = acc[ai][0][m][n][j], x2 = acc[ai][1][m][n][j];
                        o1[n][j] = (x1 * c - x2 * s) * sc; o2[n][j] = (x2 * c + x1 * s) * sc; }
                bf16_t* p = dst + (size_t)tok * pitch + cl0;
                *(u32x4*)p = pack8f(o1[0], o1[1]); *(u32x4*)(p + 128) = pack8f(o2[0], o2[1]);
                if (isk) {
                    bf16_t* kzt = (bf16_t*)(X.ws + WS_KZT) + ((size_t)(h * 64 + t) * 256) * 256; const bool odd = fr & 1; const int tokp = rl & ~1;
#pragma unroll
                    for (int hb = 0; hb < 2; ++hb)
#pragma unroll
                        for (int n = 0; n < 2; ++n)
#pragma unroll
                            for (int j = 0; j < 4; j += 2) { const float a = hb ? o2[n][j] : o1[n][j], b = hb ? o2[n][j + 1] : o1[n][j + 1];
                                const float recv = __shfl_xor(odd ? a : b, 1);
                                const int d = 128 * hb + cl0 + 4 * n + j + (odd ? 1 : 0);
                                *(unsigned*)(kzt + (size_t)d * 256 + tokp) = odd ? cvt_pk_bf16(recv, b) : cvt_pk_bf16(a, recv); }
                }
            }
    } break;
    case K_TRANS: {
        {
            const int hh = o - g.nk; bf16_t* dst = (bf16_t*)(X.ws + WS_VRH);
#pragma unroll
            for (int ai = 0; ai < 2; ++ai)
#pragma unroll
                for (int m = 0; m < 4; ++m) { const int e = 128 * ai + 16 * m + rl0; bf16_t* p = dst + ((size_t)(hh * 64 + t) * 256 + e) * 512 + cl0;
#pragma unroll
                    for (int bj = 0; bj < 2; ++bj) *(u32x4*)(p + 128 * bj) = pack8f(acc[ai][bj][m][0], acc[ai][bj][m][1]); }
        }
    } break;
    case K_S: {
        const int h = o; const float ginv = fast_exp2(-256.0f * l2gamma(h));
        bf16_t* dst = (bf16_t*)(X.ws + WS_AQ) + ((size_t)h * SEQ + 256 * t) * 512;
#pragma unroll
        for (int ai = 0; ai < 2; ++ai)
#pragma unroll
            for (int m = 0; m < 4; ++m) { const int i = 128 * ai + 16 * m + rl0;
#pragma unroll
                for (int bj = 0; bj < 2; ++bj) { const int j0 = 128 * bj + cl0; f32x4 v[2];
#pragma unroll
                    for (int n = 0; n < 2; ++n)
#pragma unroll
                        for (int j = 0; j < 4; ++j) v[n][j] = (j0 + 4 * n + j <= i) ? acc[ai][bj][m][n][j] * ginv : 0.0f;
                    *(u32x4*)(dst + (size_t)i * 512 + j0) = pack8f(v[0], v[1]); } }
    } break;
    case K_U: {
        const int h = o; bf16_t* dst = (bf16_t*)(X.ws + WS_VRH);
#pragma unroll
        for (int ai = 0; ai < 2; ++ai)
#pragma unroll
            for (int m = 0; m < 4; ++m) { const int e = 128 * ai + 16 * m + rl0; bf16_t* p = dst + ((size_t)(h * 64 + t) * 256 + e) * 512 + 256 + cl0;
#pragma unroll
                for (int bj = 0; bj < 2; ++bj) *(u32x4*)(p + 128 * bj) = pack8f(acc[ai][bj][m][0], acc[ai][bj][m][1]); }
    } break;
    case K_MAIN: {
        const int h = o; const float l2g = l2gamma(h);
        bf16_t* dst = (bf16_t*)X.out; f32x2* stat = (f32x2*)(X.ws + WS_STAT);
#pragma unroll
        for (int ai = 0; ai < 2; ++ai)
#pragma unroll
            for (int m = 0; m < 4; ++m) { const int i = 128 * ai + 16 * m + rl0, tok = 256 * t + i; const float xi = fast_exp2((float)(i + 1) * l2g);
                float s = 0.f, ss = 0.f;
#pragma unroll
                for (int bj = 0; bj < 2; ++bj) { f32x4 v0 = acc[ai][bj][m][0] * xi, v1 = acc[ai][bj][m][1] * xi;
#pragma unroll
                    for (int j = 0; j < 4; ++j) { s += v0[j] + v1[j]; ss += v0[j] * v0[j] + v1[j] * v1[j]; }
                    *(u32x4*)(dst + (size_t)tok * 2048 + h * 512 + g.hf * 256 + 128 * bj + cl0) = pack8f(v0, v1); }
                s += __shfl_xor(s, 16); s += __shfl_xor(s, 32); ss += __shfl_xor(ss, 16); ss += __shfl_xor(ss, 32);
                if (fq == 0) stat[(((size_t)tok * 4 + h) * 2 + g.hf) * 4 + wc] = (f32x2){s, ss};
            }
        if (g.hf == 1 && (wr | wc | fr | fq) == 0) __hip_atomic_fetch_add((unsigned*)(X.ws + WS_CTL) + CW_WAR, 1u, __ATOMIC_RELAXED, __HIP_MEMORY_SCOPE_AGENT);
    } break;
    case K_LOW: {
        bf16_t* CQ = (bf16_t*)(X.ws + WS_CQ); bf16_t* CKV = (bf16_t*)(X.ws + WS_CKV); bf16_t* KR = (bf16_t*)(X.ws + WS_KROPE); float* psq = (float*)(X.ws + WS_PSQ);
        int posv[2][4]; float fv[4];
        { const bool pe = (o == 2) && (cl0 < 64);
#pragma unroll
          for (int jj = 0; jj < 4; ++jj) fv[jj] = INVF[4 * (((cl0 & 63) >> 1) + jj)];
#pragma unroll
          for (int ai = 0; ai < 2; ++ai)
#pragma unroll
              for (int m = 0; m < 4; ++m) posv[ai][m] = pe ? posp[256 * t + 128 * ai + 16 * m + rl0] : 0;
          asm volatile("" : "+v"(fv[0]), "+v"(fv[1]), "+v"(fv[2]), "+v"(fv[3]), "+v"(posv[0][0]), "+v"(posv[0][1]), "+v"(posv[0][2]), "+v"(posv[0][3]), "+v"(posv[1][0]), "+v"(posv[1][1]), "+v"(posv[1][2]), "+v"(posv[1][3])); }
#pragma unroll
        for (int ai = 0; ai < 2; ++ai)
#pragma unroll
            for (int m = 0; m < 4; ++m) { const int tok = 256 * t + 128 * ai + 16 * m + rl0;
#pragma unroll
                for (int bj = 0; bj < 2; ++bj) { const int gcol = 256 * o + 128 * bj + cl0; const f32x4 v0 = acc[ai][bj][m][0], v1 = acc[ai][bj][m][1];
                    if (gcol < 640) {
                        float ss = 0.f;
#pragma unroll
                        for (int j = 0; j < 4; ++j) ss += v0[j] * v0[j] + v1[j] * v1[j];
                        ss += __shfl_xor(ss, 16); ss += __shfl_xor(ss, 32);
                        if (fq == 0) psq[(size_t)tok * 24 + (gcol >> 5)] = ss;
                        bf16_t* p = (gcol < 384) ? (CQ + (size_t)tok * 384 + gcol) : (CKV + (size_t)tok * 256 + (gcol - 384));
                        __builtin_nontemporal_store(pack8f(v0, v1), (u32x4*)p);
                    } else if (gcol < 704) {
                        const int i0 = (gcol - 640) >> 1; const float posf = (float)posv[ai][m]; f32x4 o1, o2;
#pragma unroll
                        for (int jj = 0; jj < 4; ++jj) { const float x1 = jj < 2 ? v0[2 * jj] : v1[2 * jj - 4], x2 = jj < 2 ? v0[2 * jj + 1] : v1[2 * jj - 3];
                            float s, c; sincos_ang(posf * fv[jj], s, c); o1[jj] = x1 * c - x2 * s; o2[jj] = x2 * c + x1 * s; }
                        u32x2 w1, w2; w1.x = cvt_pk_bf16(o1[0], o1[1]); w1.y = cvt_pk_bf16(o1[2], o1[3]); w2.x = cvt_pk_bf16(o2[0], o2[1]); w2.y = cvt_pk_bf16(o2[2], o2[3]);
                        *(u32x2*)(KR + (size_t)tok * 64 + i0) = w1; *(u32x2*)(KR + (size_t)tok * 64 + 32 + i0) = w2;
                    }
                } }
    } break;
    case K_QUP: {
        bf16_t* Q = (bf16_t*)(X.ws + WS_Q); const float* psq = (const float*)(X.ws + WS_PSQ);
        float fv[8];
#pragma unroll
        for (int j = 0; j < 8; ++j) fv[j] = INVF[4 * (8 * fq + j)];
        int posv[8];
#pragma unroll
        for (int q = 0; q < 8; ++q) posv[q] = (o >= 4) ? posp[256 * t + 128 * (q >> 2) + 16 * (q & 3) + rl0] : 0;
        PIN8(fv); PIN8(posv);
#pragma unroll
        for (int ai = 0; ai < 2; ++ai) {
            f32x4 sv[4][3];
#pragma unroll
            for (int m = 0; m < 4; ++m) { const int tok = 256 * t + 128 * ai + 16 * m + rl0; const f32x4* sp = (const f32x4*)(psq + (size_t)tok * 24);
                sv[m][0] = sp[0]; sv[m][1] = sp[1]; sv[m][2] = sp[2]; }
#pragma unroll
            for (int m = 0; m < 4; ++m) { const int tok = 256 * t + 128 * ai + 16 * m + rl0; const f32x4 s0 = sv[m][0], s1 = sv[m][1], s2 = sv[m][2];
                const float ssum = ((s0[0] + s0[1]) + (s0[2] + s0[3])) + ((s1[0] + s1[1]) + (s1[2] + s1[3])) + ((s2[0] + s2[1]) + (s2[2] + s2[3]));
                const float rs = __builtin_amdgcn_rsqf(ssum * (1.0f / 384.0f) + EPS) * QSCALE;
                if (o < 4) {
#pragma unroll
                    for (int bj = 0; bj < 2; ++bj) *(u32x4*)(Q + (size_t)tok * 1536 + (2 * o + bj) * 192 + cl0) = pack8f(acc[ai][bj][m][0] * rs, acc[ai][bj][m][1] * rs);
                } else {
                    const int head = (o - 4) * 4 + wc, i0 = 8 * fq; const float posf = (float)posv[4 * ai + m]; f32x4 o1[2], o2[2];
#pragma unroll
                    for (int n = 0; n < 2; ++n)
#pragma unroll
                        for (int j = 0; j < 4; ++j) { float s, c; sincos_ang(posf * fv[4 * n + j], s, c); const float x1 = acc[ai][0][m][n][j] * rs, x2 = acc[ai][1][m][n][j] * rs;
                            o1[n][j] = x1 * c - x2 * s; o2[n][j] = x2 * c + x1 * s; }
                    bf16_t* p = Q + (size_t)tok * 1536 + head * 192 + 128 + i0;
                    *(u32x4*)p = pack8f(o1[0], o1[1]); *(u32x4*)(p + 32) = pack8f(o2[0], o2[1]);
                }
            }
        }
    } break;
    case K_KVUP: {
        bf16_t* Kb = (bf16_t*)(X.ws + WS_K); bf16_t* Vb = (bf16_t*)(X.ws + WS_V); const float* psq = (const float*)(X.ws + WS_PSQ);
        const int tid = (wr * 4 + wc) * 64 + fq * 16 + fr, tokc = 256 * t + (tid >> 1), hsel = tid & 1;
        const u32x4* src = (const u32x4*)((const bf16_t*)(X.ws + WS_KROPE) + (size_t)tokc * 64 + hsel * 32);
        u32x4 rp[4];
#pragma unroll
        for (int q = 0; q < 4; ++q) rp[q] = src[q];
#pragma unroll
        for (int ai = 0; ai < 2; ++ai) {
            f32x4 sv[4][2];
#pragma unroll
            for (int m = 0; m < 4; ++m) { const int tok = 256 * t + 128 * ai + 16 * m + rl0; sv[m][0] = *(const f32x4*)(psq + (size_t)tok * 24 + 12); sv[m][1] = *(const f32x4*)(psq + (size_t)tok * 24 + 16); }
            if (ai == 0) { u32x4* dstp = (u32x4*)(Kb + (size_t)tokc * 1536 + o * 192 + 128 + hsel * 32);
#pragma unroll
                for (int q = 0; q < 4; ++q) dstp[q] = rp[q]; }
#pragma unroll
            for (int m = 0; m < 4; ++m) { const int tok = 256 * t + 128 * ai + 16 * m + rl0; const f32x4 s0 = sv[m][0], s1 = sv[m][1];
                const float ssum = ((s0[0] + s0[1]) + (s0[2] + s0[3])) + ((s1[0] + s1[1]) + (s1[2] + s1[3]));
                const float rs = __builtin_amdgcn_rsqf(ssum * (1.0f / 256.0f) + EPS);
                *(u32x4*)(Kb + (size_t)tok * 1536 + o * 192 + cl0) = pack8f(acc[ai][0][m][0] * rs, acc[ai][0][m][1] * rs);
                *(u32x4*)(Vb + (size_t)tok * 1024 + o * 128 + cl0) = pack8f(acc[ai][1][m][0] * rs, acc[ai][1][m][1] * rs);
            }
        }
    } break;
    case K_GMLA: {
        bf16_t* Ob = (bf16_t*)(X.ws + WS_O);
#pragma unroll
        for (int ai = 0; ai < 2; ++ai) {
            u32x4 ov[4][2];
#pragma unroll
            for (int m = 0; m < 4; ++m)
#pragma unroll
                for (int bj = 0; bj < 2; ++bj) ov[m][bj] = *(const u32x4*)(Ob + (size_t)(256 * t + 128 * ai + 16 * m + rl0) * 1024 + 256 * o + 128 * bj + cl0);
#pragma unroll
            for (int m = 0; m < 4; ++m) { const int tok = 256 * t + 128 * ai + 16 * m + rl0;
#pragma unroll
                for (int bj = 0; bj < 2; ++bj) { bf16_t* p = Ob + (size_t)tok * 1024 + 256 * o + 128 * bj + cl0; f32x4 a, b; unpack8(ov[m][bj], a, b);
#pragma unroll
                    for (int j = 0; j < 4; ++j) { a[j] *= siluf_(acc[ai][bj][m][0][j]); b[j] *= siluf_(acc[ai][bj][m][1][j]); }
                    *(u32x4*)p = pack8f(a, b); } }
        }
        if ((wr | wc) == 0) { const unsigned* ad = (const unsigned*)(X.ws + WS_CTL) + CW_ADONE; unsigned sp = 0;
            while ((unsigned)__builtin_amdgcn_readfirstlane((int)__hip_atomic_load(ad, __ATOMIC_RELAXED, __HIP_MEMORY_SCOPE_AGENT)) < 256u) { __builtin_amdgcn_s_sleep(4); if (++sp > (1u << 22)) break; } }
    } break;
    case K_GRET: {
        const float* const g_retp = INF(I_GRET);
        bf16_t* Ob = (bf16_t*)X.out; const float* stat = (const float*)(X.ws + WS_STAT); const int h = o >> 1;
        f32x4 gv[2][2];
#pragma unroll
        for (int bj = 0; bj < 2; ++bj) { gv[bj][0] = *(const f32x4*)(g_retp + 256 * o + 128 * bj + cl0); gv[bj][1] = *(const f32x4*)(g_retp + 256 * o + 128 * bj + cl0 + 4); }
#pragma unroll
        for (int ai = 0; ai < 2; ++ai)
#pragma unroll
            for (int mp = 0; mp < 2; ++mp) {
                f32x4 sq[2][4]; u32x4 ov[2][2];
#pragma unroll
                for (int mm = 0; mm < 2; ++mm) { const int tok = 256 * t + 128 * ai + 16 * (2 * mp + mm) + rl0; const f32x4* sp = (const f32x4*)(stat + ((size_t)tok * 4 + h) * 16);
                    sq[mm][0] = sp[0]; sq[mm][1] = sp[1]; sq[mm][2] = sp[2]; sq[mm][3] = sp[3];
#pragma unroll
                    for (int bj = 0; bj < 2; ++bj) ov[mm][bj] = *(const u32x4*)(Ob + (size_t)tok * 2048 + 256 * o + 128 * bj + cl0); }
#pragma unroll
                for (int mm = 0; mm < 2; ++mm) { const int m = 2 * mp + mm, tok = 256 * t + 128 * ai + 16 * m + rl0; const f32x4 q0 = sq[mm][0], q1 = sq[mm][1], q2 = sq[mm][2], q3 = sq[mm][3];
                    const float s = ((q0[0] + q0[2]) + (q1[0] + q1[2])) + ((q2[0] + q2[2]) + (q3[0] + q3[2])), ss = ((q0[1] + q0[3]) + (q1[1] + q1[3])) + ((q2[1] + q2[3]) + (q3[1] + q3[3]));
                    const float mean = s * (1.0f / 512.0f); const float var = __builtin_fmaxf(ss * (1.0f / 512.0f) - mean * mean, 0.0f); const float rstd = __builtin_amdgcn_rsqf(var + EPS);
#pragma unroll
                    for (int bj = 0; bj < 2; ++bj) { bf16_t* p = Ob + (size_t)tok * 2048 + 256 * o + 128 * bj + cl0; f32x4 a, b; unpack8(ov[mm][bj], a, b);
#pragma unroll
                        for (int j = 0; j < 4; ++j) { a[j] = (a[j] - mean) * rstd * gv[bj][0][j] * siluf_(acc[ai][bj][m][0][j]); b[j] = (b[j] - mean) * rstd * gv[bj][1][j] * siluf_(acc[ai][bj][m][1][j]); }
                        *(u32x4*)p = pack8f(a, b); } }
            }
    } break;
    case K_P0: case K_P2: case K_P1: case K_P3: {
        const int tid = (wr * 4 + wc) * 64 + fq * 16 + fr; const size_t so = (size_t)blockIdx.x * 16 * 512 + tid;
        u32x4* sa1 = (u32x4*)(X.ws + WS_SCRA) + so; u32x4* sb = (u32x4*)(X.ws + WS_SCRB) + so; u32x4* sa2 = (u32x4*)(X.ws + WS_SCRA2) + so;
        bf16_t* Mg = (bf16_t*)(X.ws + WS_MERGED);
        if (g.kind == K_P0 || g.kind == K_P2) {
            u32x4* sa = (g.kind == K_P0) ? sa1 : sa2;
#pragma unroll
            for (int ai = 0; ai < 2; ++ai)
#pragma unroll
                for (int bj = 0; bj < 2; ++bj)
#pragma unroll
                    for (int m = 0; m < 4; ++m) { const int rj = (ai * 2 + bj) * 4 + m; const f32x4 a = acc[ai][bj][m][0], b = acc[ai][bj][m][1]; u32x4 w;
                        w.x = cvt_pk_bf16(sigmoidf_(a[0]), sigmoidf_(a[1])); w.y = cvt_pk_bf16(sigmoidf_(a[2]), sigmoidf_(a[3]));
                        w.z = cvt_pk_bf16(sigmoidf_(b[0]), sigmoidf_(b[1])); w.w = cvt_pk_bf16(sigmoidf_(b[2]), sigmoidf_(b[3])); sa[(size_t)rj * 512] = w; }
        } else {
            const u32x4* sa = (g.kind == K_P1) ? sa1 : sa2;
#pragma unroll
            for (int ai = 0; ai < 2; ++ai) {
                u32x4 gw[2][4], tv[2][4];
#pragma unroll
                for (int bj = 0; bj < 2; ++bj)
#pragma unroll
                    for (int m = 0; m < 4; ++m) { const int rj = (ai * 2 + bj) * 4 + m; gw[bj][m] = sa[(size_t)rj * 512]; if (g.kind == K_P3) tv[bj][m] = sb[(size_t)rj * 512]; }
#pragma unroll
                for (int bj = 0; bj < 2; ++bj)
#pragma unroll
                    for (int m = 0; m < 4; ++m) { const int rj = (ai * 2 + bj) * 4 + m; f32x4 g0, g1; unpack8(gw[bj][m], g0, g1);
                        const f32x4 p0 = g0 * acc[ai][bj][m][0], p1 = g1 * acc[ai][bj][m][1];
                        if (g.kind == K_P1) sb[(size_t)rj * 512] = pack8f(p0, p1);
                        else { f32x4 t0, t1; unpack8(tv[bj][m], t0, t1); const int tok = 256 * t + 128 * ai + 16 * m + rl0;
                            *(u32x4*)(Mg + (size_t)tok * 1024 + 256 * o + 128 * bj + cl0) = pack8f(t0 + p0, t1 + p1); } }
            }
        }
    } break;
    default: break;
    }
}

__device__ __forceinline__ void epilogue_final(const Ctx& X0, f32x4 (&acc)[2][2][4][2], const Unit& u, int wr, int wc, int fr, int fq, LAS unsigned char* lds) {
    size_t z_ = 0; asm volatile("" : "+s"(z_));
    struct { unsigned char* ws; float* out; } X = {X0.ws + z_, X0.out + z_};
    asm volatile("" : "+s"(wr), "+s"(wc), "+v"(fr), "+v"(fq));
    const int t = u.t, o = u.o, cl0 = 32 * wc + 8 * fq, rl0 = 64 * wr + fr, tid = (wr * 4 + wc) * 64 + fq * 16 + fr;
    const float* const xp = INF(I_X);
    const float* gate = (const float*)(X.ws + WS_MOD) + 2048; float* fsq = (float*)(X.ws + WS_FSQ);
    unsigned* cnt = (unsigned*)(X.ws + WS_CTL) + CW_CNT + 64 * t;
    LAS u32x2* slot = (LAS u32x2*)lds + tid;
    { f32x4 gv[2][2];
#pragma unroll
    for (int bj = 0; bj < 2; ++bj) { gv[bj][0] = *(const f32x4*)(gate + 256 * o + 128 * bj + cl0); gv[bj][1] = *(const f32x4*)(gate + 256 * o + 128 * bj + cl0 + 4); }
    f32x4 xv[2][2][2][2];
#define XLOAD(b_) do { _Pragma("unroll") for (int mm = 0; mm < 2; ++mm) _Pragma("unroll") for (int bj = 0; bj < 2; ++bj) _Pragma("unroll") for (int n = 0; n < 2; ++n) \
        xv[(b_) & 1][mm][bj][n] = __builtin_nontemporal_load((const f32x4*)(xp + (size_t)(256 * t + 128 * ((b_) >> 1) + 16 * (2 * ((b_) & 1) + mm) + rl0) * 1024 + 256 * o + 128 * bj + cl0 + 4 * n)); } while (0)
    XLOAD(0);
#pragma unroll
    for (int b = 0; b < 4; ++b) { const int ai = b >> 1, mp = b & 1;
        if (b + 1 < 4) XLOAD(b + 1);
#pragma unroll
        for (int mm = 0; mm < 2; ++mm) { const int m = 2 * mp + mm, tok = 256 * t + 128 * ai + 16 * m + rl0; float ss = 0.f;
#pragma unroll
            for (int bj = 0; bj < 2; ++bj)
#pragma unroll
                for (int n = 0; n < 2; ++n) {
                    const f32x4 v = xv[b & 1][mm][bj][n] + gv[bj][n] * acc[ai][bj][m][n]; u32x2 w; w.x = cvt_pk_bf16(v[0], v[1]); w.y = cvt_pk_bf16(v[2], v[3]);
                    const f32x4 vr = {bflo(w.x), bfhi(w.x), bflo(w.y), bfhi(w.y)};
                    ss += (vr[0] * vr[0] + vr[1] * vr[1]) + (vr[2] * vr[2] + vr[3] * vr[3]); slot[(((ai * 2 + bj) * 4 + m) * 2 + n) * 512] = w; }
            ss += __shfl_xor(ss, 16); ss += __shfl_xor(ss, 32);
            if (fq == 0) __hip_atomic_store(fsq + (size_t)tok * 16 + 4 * o + wc, ss, __ATOMIC_RELAXED, __HIP_MEMORY_SCOPE_AGENT); } }
#undef XLOAD
    }
    asm volatile("s_waitcnt vmcnt(0)" ::: "memory");
    if (fq == 0 && fr == 0) __hip_atomic_fetch_add(cnt, 1u, __ATOMIC_RELAXED, __HIP_MEMORY_SCOPE_AGENT);
    { unsigned sp = 0;
      while ((unsigned)__builtin_amdgcn_readfirstlane((int)__hip_atomic_load(cnt, __ATOMIC_RELAXED, __HIP_MEMORY_SCOPE_AGENT)) < 32u) { __builtin_amdgcn_s_sleep(4); if (++sp > (1u << 22)) break; } }
    __builtin_amdgcn_fence(__ATOMIC_ACQUIRE, "agent");
    { const float* const gfin = INF(I_GFINAL);
    f32x4 gf[2][2];
#pragma unroll
    for (int bj = 0; bj < 2; ++bj) { gf[bj][0] = *(const f32x4*)(gfin + 256 * o + 128 * bj + cl0); gf[bj][1] = *(const f32x4*)(gfin + 256 * o + 128 * bj + cl0 + 4); }
    float rstd[2][4];
    { f32x4 fv[2][4][4];
#pragma unroll
      for (int ai = 0; ai < 2; ++ai)
#pragma unroll
          for (int m = 0; m < 4; ++m) { const f32x4* sp = (const f32x4*)(fsq + (size_t)(256 * t + 128 * ai + 16 * m + rl0) * 16); fv[ai][m][0] = sp[0]; fv[ai][m][1] = sp[1]; fv[ai][m][2] = sp[2]; fv[ai][m][3] = sp[3]; }
#pragma unroll
      for (int ai = 0; ai < 2; ++ai)
#pragma unroll
          for (int m = 0; m < 4; ++m) { const f32x4 a = fv[ai][m][0], b = fv[ai][m][1], c = fv[ai][m][2], d = fv[ai][m][3];
              const float ss = (((a[0] + a[1]) + (a[2] + a[3])) + ((b[0] + b[1]) + (b[2] + b[3]))) + (((c[0] + c[1]) + (c[2] + c[3])) + ((d[0] + d[1]) + (d[2] + d[3])));
              rstd[ai][m] = __builtin_amdgcn_rsqf(ss * (1.0f / DM) + EPS); } }
#pragma unroll
    for (int ai = 0; ai < 2; ++ai)
#pragma unroll
        for (int m = 0; m < 4; ++m) { const int tok = 256 * t + 128 * ai + 16 * m + rl0;
#pragma unroll
            for (int bj = 0; bj < 2; ++bj)
#pragma unroll
                for (int n = 0; n < 2; ++n) { const u32x2 w = slot[(((ai * 2 + bj) * 4 + m) * 2 + n) * 512]; const f32x4 v = {bflo(w.x), bfhi(w.x), bflo(w.y), bfhi(w.y)};
                    *(f32x4*)(X.out + (size_t)tok * 1024 + 256 * o + 128 * bj + cl0 + 4 * n) = v * rstd[ai][m] * gf[bj][n]; }
            asm volatile("" ::: "memory"); } }
}

struct Step;
__device__ __forceinline__ GCall step_call(int si);
__device__ __forceinline__ void gemm_stream(LAS unsigned char* lds, int s0, int ns, const Ctx& X) {
    const int tid = X.tid, wid = __builtin_amdgcn_readfirstlane(tid >> 6), lane = tid & 63, wr = wid >> 2, wc = wid & 3, fr = lane & 15, fq = lane >> 4;
#define PG8_VOFF(VA, VB, lda_, ldb_) do { int t_ = tid; asm volatile("" : "+v"(t_)); _Pragma("unroll") for (int i = 0; i < 2; ++i) { int R_, C_; stage_rc(t_ * 16 + i * 8192, R_, C_); \
        const int Rb_ = (R_ & ~31) + perm32(R_ & 31); VA[i] = (unsigned)(R_ * (lda_) + C_) * 2u; VB[i] = (unsigned)(Rb_ * (ldb_) + C_) * 2u; } } while (0)
    const size_t kstep = (size_t)(BK * 2);
    const unsigned ldsw = (unsigned)wid * 1024u;
    const int aoff = lds_byte(wr * 64 + fr, fq * 8), boff = lds_byte(wc * 32 + fr, fq * 8);
#define PG8_SA(b, h) (((b) * 2 + (h)) * HTB)
#define PG8_SB(b, h) ((4 + (b) * 2 + (h)) * HTB)
#define PG8_STAGE(bufoff, gbase, voff) do { _Pragma("unroll") for (int _i = 0; _i < 2; ++_i) \
        __builtin_amdgcn_global_load_lds((const unsigned*)((const char*)(gbase) + (voff)[_i]), (LAS unsigned*)(lds + (bufoff) + ldsw + _i * 8192), 16, 0, 0); } while (0)
#define PG8_LDA(dst, b, h) do { _Pragma("unroll") for (int m = 0; m < 4; ++m) _Pragma("unroll") for (int k = 0; k < 2; ++k) dst[m][k] = *(const LAS bf16x8*)(lds + PG8_SA(b, h) + aoff + m * 2048 + k * 1024); } while (0)
#define PG8_LDB(dst, b, h) do { _Pragma("unroll") for (int n = 0; n < 2; ++n) _Pragma("unroll") for (int k = 0; k < 2; ++k) dst[n][k] = *(const LAS bf16x8*)(lds + PG8_SB(b, h) + boff + n * 2048 + k * 1024); } while (0)
#define PG8_MMA(ai, bj, At, Bt) do { __builtin_amdgcn_s_setprio(1); _Pragma("unroll") for (int m = 0; m < 4; ++m) _Pragma("unroll") for (int n = 0; n < 2; ++n) _Pragma("unroll") for (int k = 0; k < 2; ++k) \
        acc[ai][bj][m][n] = __builtin_amdgcn_mfma_f32_16x16x32_bf16(Bt[n][k], At[m][k], acc[ai][bj][m][n], 0, 0, 0); __builtin_amdgcn_s_setprio(0); } while (0)
#define PG8_WAIT_V(n) asm volatile("s_waitcnt vmcnt(" #n ")" ::: "memory")
#define PG8_WAIT_L(n) asm volatile("s_waitcnt lgkmcnt(" #n ")" ::: "memory")
#define PG8_BAR __builtin_amdgcn_s_barrier()
#define PG8_SCHED __builtin_amdgcn_sched_barrier(0)
#define PG8_KBODY(a1, a2, a3, b2, b3, VA2, VB2, HA2, HB2) do { \
        PG8_LDB(B0, 0, 0); PG8_LDB(B1, 0, 1); PG8_SCHED; PG8_LDA(At, 0, 0); PG8_STAGE(PG8_SA(1, 1), (a1) + hstepA, voffA); \
        PG8_WAIT_V(8); PG8_WAIT_L(0); PG8_BAR; PG8_MMA(0, 0, At, B0); PG8_MMA(0, 1, At, B1); PG8_BAR; PG8_SCHED; \
        PG8_LDA(At, 0, 1); PG8_STAGE(PG8_SB(0, 0), (b2), VB2); PG8_STAGE(PG8_SB(0, 1), (b2) + (HB2), VB2); PG8_STAGE(PG8_SA(0, 0), (a2), VA2); \
        PG8_WAIT_V(8); PG8_WAIT_L(0); PG8_BAR; PG8_MMA(1, 0, At, B0); PG8_MMA(1, 1, At, B1); PG8_BAR; PG8_SCHED; \
        PG8_LDB(B0, 1, 0); PG8_LDB(B1, 1, 1); PG8_SCHED; PG8_LDA(At, 1, 0); PG8_STAGE(PG8_SA(0, 1), (a2) + (HA2), VA2); \
        PG8_WAIT_V(8); PG8_WAIT_L(0); PG8_BAR; PG8_MMA(0, 0, At, B0); PG8_MMA(0, 1, At, B1); PG8_BAR; PG8_SCHED; \
        PG8_LDA(At, 1, 1); PG8_STAGE(PG8_SB(1, 0), (b3), VB2); PG8_STAGE(PG8_SB(1, 1), (b3) + (HB2), VB2); PG8_STAGE(PG8_SA(1, 0), (a3), VA2); \
        PG8_WAIT_V(8); PG8_WAIT_L(0); PG8_BAR; PG8_MMA(1, 0, At, B0); PG8_MMA(1, 1, At, B1); PG8_BAR; PG8_SCHED; } while (0)
    int seg = 0, ui = 0; GCall g = step_call(s0); Unit cur;
    while (!unit_next(g, X.vcu, ui, cur)) { if (++seg >= ns) return; g = step_call(s0 + seg); ui = 0; }
    unsigned voffA[2], voffB[2], nvoffA[2], nvoffB[2];
    PG8_VOFF(voffA, voffB, g.lda, g.ldb);
    size_t hstepA = (size_t)HALF * g.lda * 2, hstepB = (size_t)HALF * g.ldb * 2;
    int nt = g.K / BK;
    f32x4 acc[2][2][4][2];
#pragma unroll
    for (int a = 0; a < 2; ++a)
#pragma unroll
        for (int b = 0; b < 2; ++b)
#pragma unroll
            for (int m = 0; m < 4; ++m)
#pragma unroll
                for (int n = 0; n < 2; ++n) acc[a][b][m][n] = (f32x4){0.f, 0.f, 0.f, 0.f};
    bf16x8 At[4][2], B0[2][2], B1[2][2];
    const char* cA; const char* cB; unit_ptrs(g, X, cur, cA, cB);
    PG8_STAGE(PG8_SB(0, 0), cB, voffB); PG8_STAGE(PG8_SB(0, 1), cB + hstepB, voffB); PG8_STAGE(PG8_SA(0, 0), cA, voffA); PG8_STAGE(PG8_SA(0, 1), cA + hstepA, voffA);
    if (wr == 1) PG8_BAR;
    PG8_WAIT_V(2); PG8_BAR;
    PG8_STAGE(PG8_SB(1, 0), cB + kstep, voffB); PG8_STAGE(PG8_SA(1, 0), cA + kstep, voffA); PG8_STAGE(PG8_SB(1, 1), cB + hstepB + kstep, voffB);
    PG8_WAIT_V(6); PG8_BAR;
    for (;;) {
        GCall ng = g; Unit nxt; int nseg = seg, nui = ui + 1; bool has_next = true;
        while (!unit_next(ng, X.vcu, nui, nxt)) { if (++nseg >= ns) { has_next = false; break; } ng = step_call(s0 + nseg); nui = 0; }
        const char* nA = cA; const char* nB = cB; size_t nhstepA = hstepA, nhstepB = hstepB;
#pragma unroll
        for (int i = 0; i < 2; ++i) { nvoffA[i] = voffA[i]; nvoffB[i] = voffB[i]; }
        if (has_next) { unit_ptrs(ng, X, nxt, nA, nB); nhstepA = (size_t)HALF * ng.lda * 2; nhstepB = (size_t)HALF * ng.ldb * 2;
            if (nseg != seg) PG8_VOFF(nvoffA, nvoffB, ng.lda, ng.ldb); }
        for (int t = 0; t < nt - 2; t += 2) {
            const char* a1 = cA + (size_t)(t + 1) * kstep; const char* a2 = cA + (size_t)(t + 2) * kstep; const char* b2 = cB + (size_t)(t + 2) * kstep;
            PG8_KBODY(a1, a2, a2 + kstep, b2, b2 + kstep, voffA, voffB, hstepA, hstepB);
        }
        { const char* a1 = cA + (size_t)(nt - 1) * kstep;
          PG8_KBODY(a1, nA, nA + kstep, nB, nB + kstep, nvoffA, nvoffB, nhstepA, nhstepB); }
        if (wr == 0) PG8_BAR;
        if (g.kind != K_FINAL) epilogue(g, X, acc, cur, wr, wc, fr, fq);
        if (!has_next) break;
#pragma unroll
        for (int a = 0; a < 2; ++a)
#pragma unroll
            for (int b = 0; b < 2; ++b)
#pragma unroll
                for (int m = 0; m < 4; ++m)
#pragma unroll
                    for (int n = 0; n < 2; ++n) acc[a][b][m][n] = (f32x4){0.f, 0.f, 0.f, 0.f};
        cur = nxt; cA = nA; cB = nB; g = ng; seg = nseg; ui = nui; hstepA = nhstepA; hstepB = nhstepB; nt = g.K / BK;
#pragma unroll
        for (int i = 0; i < 2; ++i) { voffA[i] = nvoffA[i]; voffB[i] = nvoffB[i]; }
        if (wr == 1) PG8_BAR;
    }
    PG8_WAIT_V(0);
    PG8_BAR;
    if (g.kind == K_FINAL) epilogue_final(X, acc, cur, wr, wc, fr, fq, lds);
#undef PG8_KBODY
#undef PG8_VOFF
#undef PG8_SA
#undef PG8_SB
#undef PG8_STAGE
#undef PG8_LDA
#undef PG8_LDB
#undef PG8_MMA
#undef PG8_WAIT_V
#undef PG8_WAIT_L
#undef PG8_BAR
#undef PG8_SCHED
}

namespace att16 {
constexpr int QP = 1536, VP = 1024, OP = 1024;
constexpr int KROWB = 416, VROWB = 288;
constexpr int SHM_K = 64 * KROWB, SHM_V = 64 * VROWB;
constexpr int LDS_V = 0, LDS_K = 2 * SHM_V, LDS_TOTAL = LDS_K + 2 * SHM_K;
constexpr float THR2 = 11.5f;
typedef __attribute__((address_space(3))) const char* lds_cptr;
typedef short v4i16_t __attribute__((ext_vector_type(4)));
#define SBAR() __builtin_amdgcn_sched_barrier(0)
__device__ __forceinline__ s16x4 vtr(lds_cptr p) { return __builtin_bit_cast(s16x4, __builtin_amdgcn_ds_read_tr16_b64_v4i16((__attribute__((address_space(3))) v4i16_t*)p)); }
__device__ __forceinline__ bf16x8 kfr(lds_cptr p) { return *(const __attribute__((address_space(3))) bf16x8*)p; }
__device__ __forceinline__ float xmax16(float x) {
    auto r = __builtin_amdgcn_permlane16_swap(__float_as_uint(x), __float_as_uint(x), false, false); x = fmaxf(__uint_as_float(r[0]), __uint_as_float(r[1]));
    auto r2 = __builtin_amdgcn_permlane32_swap(__float_as_uint(x), __float_as_uint(x), false, false); return fmaxf(__uint_as_float(r2[0]), __uint_as_float(r2[1]));
}
__device__ __forceinline__ float xsum16(float x) {
    auto r = __builtin_amdgcn_permlane16_swap(__float_as_uint(x), __float_as_uint(x), false, false); x = __uint_as_float(r[0]) + __uint_as_float(r[1]);
    auto r2 = __builtin_amdgcn_permlane32_swap(__float_as_uint(x), __float_as_uint(x), false, false); return __uint_as_float(r2[0]) + __uint_as_float(r2[1]);
}
#define MM16(acc_, a_, b_) acc_ = __builtin_amdgcn_mfma_f32_16x16x32_bf16(a_, b_, acc_, 0, 0, 0)
__device__ __forceinline__ void attn_unit(const bf16_t* Qh, const bf16_t* Kh, const bf16_t* Vh, bf16_t* Oh, int q0, char* lds, int tid) {
    asm volatile("" : "+v"(tid));
    const int wid = __builtin_amdgcn_readfirstlane(tid >> 6), lane = tid & 63, c = lane & 15, g = lane >> 4;
    const int NT = (q0 + 256) / 64;
    const int qlo = q0 + wid * 32;
    char* V_lds = lds + LDS_V; char* K_lds = lds + LDS_K;
    const int sr = tid >> 4, sc = (tid & 15) * 8, vst0 = sr * VROWB + sc * 2;
    int krc[3];
#pragma unroll
    for (int i = 0; i < 3; ++i) { const int q = tid + 512 * i, row = q / 24, cc = q - row * 24; krc[i] = (row << 5) | cc; }
    const lds_cptr l3 = (lds_cptr)lds;
    const lds_cptr kp0 = l3 + LDS_K + c * KROWB + g * 16;
    const lds_cptr vp0 = l3 + LDS_V + (4 * g + (c >> 2)) * VROWB + 8 * (c & 3);
    bf16x8 qf[2][6];
#pragma unroll
    for (int qb = 0; qb < 2; ++qb)
#pragma unroll
        for (int ks = 0; ks < 6; ++ks) qf[qb][ks] = *reinterpret_cast<const bf16x8*>(Qh + (size_t)(qlo + 16 * qb + c) * QP + 32 * ks + 8 * g);
    bf16x8 sa0, sa1, sa2, sb0, sb1, sb2, sv0, sv1;
#define KOFF(i, rowmul, ccmul) ({ const int k_ = krc[i]; (k_ >> 5) * (rowmul) + (k_ & 31) * (ccmul); })
#define KLOAD(tt, k0_, k1_, k2_) do { const bf16_t* kp_ = Kh + (size_t)(tt) * 64 * QP; \
        k0_ = *reinterpret_cast<const bf16x8*>(kp_ + KOFF(0, QP, 8)); k1_ = *reinterpret_cast<const bf16x8*>(kp_ + KOFF(1, QP, 8)); k2_ = *reinterpret_cast<const bf16x8*>(kp_ + KOFF(2, QP, 8)); } while (0)
#define VLOAD(tt) do { const bf16_t* vp_ = Vh + (size_t)(tt) * 64 * VP + (size_t)sr * VP + sc; sv0 = *reinterpret_cast<const bf16x8*>(vp_); sv1 = *reinterpret_cast<const bf16x8*>(vp_ + 32 * VP); } while (0)
#define KWRITE(ko, k0_, k1_, k2_) do { *(bf16x8*)(K_lds + (ko) + KOFF(0, KROWB, 16)) = k0_; *(bf16x8*)(K_lds + (ko) + KOFF(1, KROWB, 16)) = k1_; *(bf16x8*)(K_lds + (ko) + KOFF(2, KROWB, 16)) = k2_; } while (0)
#define VWRITE(vo) do { *(bf16x8*)(V_lds + (vo) + vst0) = sv0; *(bf16x8*)(V_lds + (vo) + vst0 + 32 * VROWB) = sv1; } while (0)
    float l_reg[2] = {0.f, 0.f};
    f32x4 negm[2] = {(f32x4){0.f, 0.f, 0.f, 0.f}, (f32x4){0.f, 0.f, 0.f, 0.f}};
    f32x4 o[8][2];
#pragma unroll
    for (int db = 0; db < 8; ++db) { o[db][0] = (f32x4){0.f, 0.f, 0.f, 0.f}; o[db][1] = (f32x4){0.f, 0.f, 0.f, 0.f}; }
    KLOAD(0, sa0, sa1, sa2); VLOAD(0); KWRITE(0, sa0, sa1, sa2); VWRITE(0); KLOAD(1, sa0, sa1, sa2); VLOAD(1); KLOAD(2, sb0, sb1, sb2); __syncthreads();
    int kcur = 0, vcur = 0;
#define ASTEP(t, k0_, k1_, k2_) do { \
        SBAR(); \
        step_s(t); \
        SBAR(); \
        step_pv(t); \
        SBAR(); \
        KWRITE(kcur ^ SHM_K, k0_, k1_, k2_); VWRITE(vcur ^ SHM_V);     \
        KLOAD(min((t) + 3, NT - 1), k0_, k1_, k2_);                       \
        VLOAD(min((t) + 2, NT - 1)); \
        __syncthreads(); \
        kcur ^= SHM_K; vcur ^= SHM_V; } while (0)
    bf16x8 pf[2][2]; bool act; s16x4 vl[3], vh[3];
    auto step_s = [&](int t) __attribute__((always_inline)) {
        act = 64 * t <= qlo + 31;
        if (act) {
        f32x4 s[4][2];
        { const lds_cptr kp = kp0 + kcur; bf16x8 kf[4];
#pragma unroll
          for (int kb = 0; kb < 4; ++kb) kf[kb] = kfr(kp + kb * 16 * KROWB);
          SBAR();
#pragma unroll
          for (int ks = 0; ks < 6; ++ks)
#pragma unroll
              for (int kb = 0; kb < 4; ++kb) {
                  if (ks == 0) { s[kb][0] = __builtin_amdgcn_mfma_f32_16x16x32_bf16(kf[kb], qf[0][0], negm[0], 0, 0, 0); s[kb][1] = __builtin_amdgcn_mfma_f32_16x16x32_bf16(kf[kb], qf[1][0], negm[1], 0, 0, 0); }
                  else { MM16(s[kb][0], kf[kb], qf[0][ks]); MM16(s[kb][1], kf[kb], qf[1][ks]); }
                  if (ks < 5) kf[kb] = kfr(kp + kb * 16 * KROWB + (ks + 1) * 64);
                  SBAR(); } }
        { const lds_cptr vp = vp0 + vcur;
#pragma unroll
          for (int db = 0; db < 3; ++db) { vl[db] = vtr(vp + 32 * db); vh[db] = vtr(vp + 16 * VROWB + 32 * db); } }
        SBAR();
        if (64 * t + 63 > qlo) {
            const float NEG = -__builtin_inff();
#pragma unroll
            for (int kb = 0; kb < 4; ++kb)
#pragma unroll
                for (int qb = 0; qb < 2; ++qb)
#pragma unroll
                    for (int r = 0; r < 4; ++r) if (64 * t + 16 * kb + 4 * g + r > qlo + 16 * qb + c) s[kb][qb][r] = NEG;
        }
        float pm[2];
#pragma unroll
        for (int qb = 0; qb < 2; ++qb) { float a = fmaxf(fmaxf(s[0][qb][0], s[0][qb][1]), s[0][qb][2]), b = fmaxf(fmaxf(s[0][qb][3], s[1][qb][0]), s[1][qb][1]);
            a = fmaxf(fmaxf(a, s[1][qb][2]), s[1][qb][3]); b = fmaxf(fmaxf(b, s[2][qb][0]), s[2][qb][1]); a = fmaxf(fmaxf(a, s[2][qb][2]), s[2][qb][3]);
            b = fmaxf(fmaxf(b, s[3][qb][0]), s[3][qb][1]); a = fmaxf(fmaxf(a, s[3][qb][2]), s[3][qb][3]); pm[qb] = fmaxf(a, b); }
        if (__builtin_expect(t == 0 || !__all(fmaxf(pm[0], pm[1]) <= THR2), 0)) {
#pragma unroll
            for (int qb = 0; qb < 2; ++qb) { const float pmx = xmax16(pm[qb]); const float d = (t == 0) ? pmx : fmaxf(pmx, 0.f); const float al = __builtin_amdgcn_exp2f(-d); negm[qb] -= d; l_reg[qb] *= al;
#pragma unroll
                for (int kb = 0; kb < 4; ++kb) s[kb][qb] -= d;
#pragma unroll
                for (int db = 0; db < 8; ++db) o[db][qb] *= al; }
        }
#pragma unroll
        for (int qb = 0; qb < 2; ++qb) {
#pragma unroll
            for (int kb = 0; kb < 4; ++kb)
#pragma unroll
                for (int r = 0; r < 4; ++r) s[kb][qb][r] = __builtin_amdgcn_exp2f(s[kb][qb][r]);
            { float la = s[0][qb][0] + s[0][qb][1], lb = s[0][qb][2] + s[0][qb][3];
              asm volatile("" : "+v"(la), "+v"(lb));
#pragma unroll
              for (int kb = 1; kb < 4; ++kb) { la += s[kb][qb][0]; lb += s[kb][qb][2]; asm volatile("" : "+v"(la), "+v"(lb)); la += s[kb][qb][1]; lb += s[kb][qb][3]; asm volatile("" : "+v"(la), "+v"(lb)); }
              l_reg[qb] += la + lb; }
#pragma unroll
            for (int sp = 0; sp < 2; ++sp) { u32x4 w; w.x = cvt_pk_bf16(s[2 * sp][qb][0], s[2 * sp][qb][1]); w.y = cvt_pk_bf16(s[2 * sp][qb][2], s[2 * sp][qb][3]);
                w.z = cvt_pk_bf16(s[2 * sp + 1][qb][0], s[2 * sp + 1][qb][1]); w.w = cvt_pk_bf16(s[2 * sp + 1][qb][2], s[2 * sp + 1][qb][3]); pf[sp][qb] = *reinterpret_cast<bf16x8*>(&w); }
        }
        }
    };
    auto step_pv = [&](int t) __attribute__((always_inline)) {
        if (act)
        { const lds_cptr vp = vp0 + vcur;
#pragma unroll
          for (int i = 0; i < 16; ++i) { const int sp = i >> 3, db = i & 7, sl = i % 3;
              const bf16x8 vf = (bf16x8){vl[sl][0], vl[sl][1], vl[sl][2], vl[sl][3], vh[sl][0], vh[sl][1], vh[sl][2], vh[sl][3]};
              MM16(o[db][0], vf, pf[sp][0]); MM16(o[db][1], vf, pf[sp][1]);
              if (i + 3 < 16) { const int sp2 = (i + 3) >> 3, db2 = (i + 3) & 7; vl[sl] = vtr(vp + (32 * sp2) * VROWB + 32 * db2); vh[sl] = vtr(vp + (32 * sp2 + 16) * VROWB + 32 * db2); }
              SBAR(); } }
    };
    for (int t = 0; t < NT; t += 2) {
        ASTEP(t, sa0, sa1, sa2);
        ASTEP(t + 1, sb0, sb1, sb2);
    }
#undef ASTEP
#undef KLOAD
#undef VLOAD
#undef KWRITE
#undef VWRITE
#undef KOFF
#pragma unroll
    for (int qb = 0; qb < 2; ++qb) { const float rl = __builtin_amdgcn_rcpf(xsum16(l_reg[qb])); bf16_t* Ow = Oh + (size_t)(qlo + 16 * qb + c) * OP + 8 * (g >> 1) + 16 * (g & 1);
#pragma unroll
        for (int j = 0; j < 4; ++j) { const f32x4 ve = o[2 * j][qb] * rl, vo = o[2 * j + 1][qb] * rl;
            const unsigned ex = cvt_pk_bf16(ve[0], ve[1]), ey = cvt_pk_bf16(ve[2], ve[3]), ox = cvt_pk_bf16(vo[0], vo[1]), oy = cvt_pk_bf16(vo[2], vo[3]);
            auto rx = __builtin_amdgcn_permlane16_swap(ex, ox, false, false); auto ry = __builtin_amdgcn_permlane16_swap(ey, oy, false, false);
            __hip_atomic_store((unsigned long long*)(Ow + 32 * j), ((unsigned long long)ry[0] << 32) | rx[0], __ATOMIC_RELAXED, __HIP_MEMORY_SCOPE_AGENT);
            __hip_atomic_store((unsigned long long*)(Ow + 32 * j) + 1, ((unsigned long long)ry[1] << 32) | rx[1], __ATOMIC_RELAXED, __HIP_MEMORY_SCOPE_AGENT); } }
    __syncthreads();
}
#undef SBAR
#undef MM16
}

__device__ __forceinline__ int win_src(int n) {
    if (n < 1024) return 1728 + n;
    if (n < 2048) return 2752 + (n - 1024);
    if (n < 4096) return 3776 + (n - 2048);
    if (n < 6144) return 5824 + (n - 4096);
    if (n < 7168) return 704 + (n - 6144);
    if (n < 8192) return 7872 + (n - 7168);
    if (n < 9216) return 8896 + (n - 8192);
    const int m = n - 9216;
    if (m < 640) return m;
    if (m < 704) { const int p = m - 640; return 640 + ((p & 1) ? 32 + (p >> 1) : (p >> 1)); }
    return -1;
}
__device__ __forceinline__ int wq_src(int n) {
    if (n < 1024) { const int t = n >> 8, bj = (n >> 7) & 1, i = n & 127; return (2 * t + bj) * 192 + i; }
    const int m = n - 1024, t4 = m >> 8, bj = (m >> 7) & 1, hh = (m >> 5) & 3, i = m & 31; return (t4 * 4 + hh) * 192 + 128 + bj * 32 + i;
}
template <int WHICH, bool SC>
__device__ __forceinline__ void transpose_item(const float* W, int K, int Nsrc, int nkb, const float* kscale, bf16_t* WT, LAS float* scr, int item, int lane) {
    const int nb = item / nkb, kb = item - nb * nkb, k0 = 64 * kb, n0 = 64 * nb;
    float tv[2][32];
#pragma unroll
    for (int s = 0; s < 2; ++s) { const int n = n0 + 32 * s + (lane & 31); const int src = WHICH == 0 ? win_src(n) : WHICH == 1 ? wq_src(n) : n;
#pragma unroll
        for (int i = 0; i < 32; ++i) { const int kk = 2 * i + (lane >> 5); float v = 0.f; if (src >= 0) v = __builtin_nontemporal_load(&W[(size_t)(k0 + kk) * Nsrc + src]); tv[s][i] = v; } }
    f32x4 ks0 = {1.f, 1.f, 1.f, 1.f}, ks1 = ks0; if (SC) { ks0 = *(const f32x4*)(kscale + k0 + 8 * (lane & 7)); ks1 = *(const f32x4*)(kscale + k0 + 8 * (lane & 7) + 4); }
#pragma unroll
    for (int s = 0; s < 2; ++s) {
#pragma unroll
        for (int i = 0; i < 32; ++i) { const int kk = 2 * i + (lane >> 5); scr[kk * 33 + (lane & 31)] = tv[s][i]; }
        LDS_WAIT(); asm volatile("" ::: "memory");
        const int c = lane & 7;
#pragma unroll
        for (int j = 0; j < 4; ++j) { const int nn = (lane >> 3) + 8 * j; const LAS float* sp = scr + (8 * c) * 33 + nn;
            u32x4 o; if (SC) { o.x = pk2(sp[0 * 33] * ks0[0], sp[1 * 33] * ks0[1]); o.y = pk2(sp[2 * 33] * ks0[2], sp[3 * 33] * ks0[3]); o.z = pk2(sp[4 * 33] * ks1[0], sp[5 * 33] * ks1[1]); o.w = pk2(sp[6 * 33] * ks1[2], sp[7 * 33] * ks1[3]); }
            else { o.x = pk2(sp[0 * 33], sp[1 * 33]); o.y = pk2(sp[2 * 33], sp[3 * 33]); o.z = pk2(sp[4 * 33], sp[5 * 33]); o.w = pk2(sp[6 * 33], sp[7 * 33]); }
            *(u32x4*)(WT + (size_t)(n0 + 32 * s + nn) * K + k0 + 8 * c) = o; }
        LDS_WAIT(); asm volatile("" ::: "memory"); }
}
__device__ __forceinline__ void phase_prep(const Ctx& X, LAS unsigned char* lds) {
    for (int it = blockIdx.x; it < 8 * 12; it += X.G) {
        const int ks8 = it / 12, jb = it - ks8 * 12, col = jb * 256 + (X.tid & 255), slice = ks8 * 2 + (X.tid >> 8);
        float a = 0.f; const float* const cp = INF(I_C); const float* const wa = INF(I_WADA);
#pragma unroll 1
        for (int k0 = slice * 64; k0 < slice * 64 + 64; k0 += 32) { float w[32];
#pragma unroll
            for (int k = 0; k < 32; ++k) w[k] = __builtin_nontemporal_load(&wa[(size_t)(k0 + k) * 3072 + col]);
#pragma unroll
            for (int k = 0; k < 32; ++k) a += siluf_(cp[k0 + k]) * w[k]; }
        __hip_atomic_store((float*)(X.ws + WS_MODP) + slice * 3072 + col, a, __ATOMIC_RELAXED, __HIP_MEMORY_SCOPE_AGENT);
    }
    if (blockIdx.x < 8 * 12) {
        VM_WAIT(); __syncthreads();
        if (X.tid == 0) {
            __hip_atomic_fetch_add((unsigned*)(X.ws + WS_CTL) + CW_GEMV, 1u, __ATOMIC_RELAXED, __HIP_MEMORY_SCOPE_AGENT); }
    }
    LAS float* scr = (LAS float*)(lds + X.wave * 16384);
    const int gw = X.vcu * NWAVES + X.wave, NGW = X.G * NWAVES;
    constexpr int I_IN = (NWIN / 64) * 16, I_Q = (1536 / 64) * 6, I_KV = (2048 / 64) * 4, I_PM = 16 * 16, I_PR = 16 * 32, I_O = 16 * 16;
    constexpr int NITEMS = I_IN + I_Q + I_KV + I_PM + I_PR + I_O;
    for (int it = gw; it < NITEMS; it += NGW) {
        int r = it;
        if (r < I_IN) { transpose_item<0, false>(INF(I_WIN), 1024, 9920, 16, nullptr, (bf16_t*)(X.ws + WS_WIN), scr, r, X.lane); continue; } r -= I_IN;
        if (r < I_Q) { transpose_item<1, true>(INF(I_WQUP), 384, 1536, 6, INF(I_GQ), (bf16_t*)(X.ws + WS_WQ), scr, r, X.lane); continue; } r -= I_Q;
        if (r < I_KV) { transpose_item<2, true>(INF(I_WKVUP), 256, 2048, 4, INF(I_GKV), (bf16_t*)(X.ws + WS_WKV), scr, r, X.lane); continue; } r -= I_KV;
        if (r < I_PM) { transpose_item<2, false>(INF(I_WPM), 1024, 1024, 16, nullptr, (bf16_t*)(X.ws + WS_WPM), scr, r, X.lane); continue; } r -= I_PM;
        if (r < I_PR) { transpose_item<2, false>(INF(I_WPR), 2048, 1024, 32, nullptr, (bf16_t*)(X.ws + WS_WPR), scr, r, X.lane); continue; } r -= I_PR;
        transpose_item<2, false>(INF(I_WOUT), 1024, 1024, 16, nullptr, (bf16_t*)(X.ws + WS_WO), scr, r, X.lane);
    }
}
__device__ __forceinline__ void phase_h(const Ctx& X, LAS unsigned char* lds) {
    LAS float* modl = (LAS float*)lds;
    if (X.tid == 0) { unsigned sp = 0; const unsigned* cg = (const unsigned*)(X.ws + WS_CTL) + CW_GEMV;
        while (__hip_atomic_load(cg, __ATOMIC_RELAXED, __HIP_MEMORY_SCOPE_AGENT) < 96u) { __builtin_amdgcn_s_sleep(8); if (++sp > (1u << 22)) break; }
        __builtin_amdgcn_fence(__ATOMIC_ACQUIRE, "agent"); asm volatile("s_waitcnt vmcnt(0)" ::: "memory"); }
    __syncthreads();
    const float* const badap = INF(I_BADA); const float* const gprep = INF(I_GPRE); const float* const xp = INF(I_X);
    { float pv[4][16], bv[4];
#pragma unroll
      for (int q = 0; q < 4; ++q) { const float* mp = (const float*)(X.ws + WS_MODP) + X.tid + 512 * q; bv[q] = badap[X.tid + 512 * q];
#pragma unroll
          for (int s = 0; s < 16; ++s) pv[q][s] = mp[s * 3072]; }
#pragma unroll
      for (int q = 0; q < 4; ++q) { const int j = X.tid + 512 * q; float a = bv[q];
#pragma unroll
          for (int s = 0; s < 16; ++s) a += pv[q][s];
          modl[j] = a; if (blockIdx.x == 0) ((float*)(X.ws + WS_MOD))[j] = a; } }
    if (blockIdx.x == 0) {
        float pv[2][16], bv[2];
#pragma unroll
        for (int q = 0; q < 2; ++q) { const float* mp = (const float*)(X.ws + WS_MODP) + 2048 + X.tid + 512 * q; bv[q] = badap[2048 + X.tid + 512 * q];
#pragma unroll
            for (int s = 0; s < 16; ++s) pv[q][s] = mp[s * 3072]; }
#pragma unroll
        for (int q = 0; q < 2; ++q) { float a = bv[q];
#pragma unroll
            for (int s = 0; s < 16; ++s) a += pv[q][s];
            ((float*)(X.ws + WS_MOD))[2048 + X.tid + 512 * q] = a; } }
    __syncthreads();
    f32x4 ca[4], cb[4];
#pragma unroll
    for (int j = 0; j < 4; ++j) { const int col = 256 * j + 4 * X.lane;
#pragma unroll
        for (int q = 0; q < 4; ++q) { ca[j][q] = gprep[col + q] * (1.0f + modl[1024 + col + q]); cb[j][q] = modl[col + q]; } }
    const int gw = X.vcu * NWAVES + X.wave, NGW = X.G * NWAVES;
    {
        f32x4 v[8][4];
#pragma unroll
        for (int r = 0; r < 8; ++r) { const f32x4* xr = (const f32x4*)(xp + (size_t)(gw + r * NGW) * DM) + X.lane;
#pragma unroll
            for (int j = 0; j < 4; ++j) v[r][j] = __builtin_nontemporal_load(&xr[64 * j]); }
#pragma unroll
        for (int r = 0; r < 8; ++r) { float s2 = 0.f;
#pragma unroll
            for (int j = 0; j < 4; ++j) s2 += (v[r][j][0] * v[r][j][0] + v[r][j][1] * v[r][j][1]) + (v[r][j][2] * v[r][j][2] + v[r][j][3] * v[r][j][3]);
            const float rstd = __builtin_amdgcn_rsqf(wave_sum(s2) * (1.0f / DM) + EPS);
            u32x2* o8 = (u32x2*)((bf16_t*)(X.ws + WS_H) + (size_t)(gw + r * NGW) * DM) + X.lane;
#pragma unroll
            for (int j = 0; j < 4; ++j) { const f32x4 y = v[r][j] * rstd * ca[j] + cb[j]; u32x2 w; w.x = pk2(y[0], y[1]); w.y = pk2(y[2], y[3]);
                __hip_atomic_store((unsigned long long*)(o8 + 64 * j), ((unsigned long long)w.y << 32) | w.x, __ATOMIC_RELAXED, __HIP_MEMORY_SCOPE_AGENT); } }
    }
    __syncthreads();
}
__device__ __forceinline__ void phase_scan(const Ctx& X) {
    const int gt = blockIdx.x * NTHR + X.tid;
    const int h = gt >> 15, e = (gt >> 7) & 255, d2 = gt & 127; const float g = fast_exp2(256.0f * l2gamma(h));
    unsigned* p = (unsigned*)((bf16_t*)(X.ws + WS_VRH) + ((size_t)(h * 64) * 256 + e) * 512 + 256 + 2 * d2);
    float r0 = 0.f, r1 = 0.f;
#pragma unroll 1
    for (int c0 = 0; c0 < 64; c0 += 32) {
        unsigned u[32];
#pragma unroll
        for (int c = 0; c < 32; ++c) u[c] = p[(size_t)(c0 + c) * 65536];
#pragma unroll
        for (int c = 0; c < 32; ++c) { __hip_atomic_store(&p[(size_t)(c0 + c) * 65536], cvt_pk_bf16(r0, r1), __ATOMIC_RELAXED, __HIP_MEMORY_SCOPE_AGENT); r0 = g * r0 + bflo(u[c]); r1 = g * r1 + bfhi(u[c]); }
    }
}
__device__ __forceinline__ void phase_norm(const Ctx& X) {
    const int gw = X.vcu * NWAVES + X.wave, NGW = X.G * NWAVES; const float* fsq = (const float*)(X.ws + WS_FSQ);
    f32x4 gf[4];
#pragma unroll
    for (int j = 0; j < 4; ++j) gf[j] = *((const f32x4*)INF(I_GFINAL) + 64 * j + X.lane);
    for (int m0 = gw; m0 < SEQ; m0 += 4 * NGW) {
        f32x4 v[4][4], q[4][4];
#pragma unroll
        for (int r = 0; r < 4; ++r) { const int m = m0 + r * NGW; const f32x4* sp = (const f32x4*)(fsq + (size_t)m * 16); const f32x4* xr = (const f32x4*)(X.out + (size_t)m * DM) + X.lane;
#pragma unroll
            for (int j = 0; j < 4; ++j) { q[r][j] = sp[j]; v[r][j] = xr[64 * j]; } }
#pragma unroll
        for (int r = 0; r < 4; ++r) { const int m = m0 + r * NGW; float ss = 0.f;
#pragma unroll
            for (int j = 0; j < 4; ++j) ss += (q[r][j][0] + q[r][j][1]) + (q[r][j][2] + q[r][j][3]);
            const float rstd = 1.0f / sqrtf(ss * (1.0f / DM) + EPS);
            f32x4* xr = (f32x4*)(X.out + (size_t)m * DM) + X.lane;
#pragma unroll
            for (int j = 0; j < 4; ++j) xr[64 * j] = v[r][j] * rstd * gf[j]; }
    }
}

enum Op { OP_PREP = 0, OP_H, OP_GEMM, OP_SCAN, OP_ATTN, OP_NORM };
enum Sync { SY_NONE = 0, SY_LOCAL, SY_GRID, SY_PANEL, SY_AFLAG, SY_WAR };
struct Step { int op, sync; GCall g; };
__device__ const Step STEPS[] = {
    {OP_PREP, SY_NONE, {0, 0, 0, 0, 0, 0, 0}},
    {OP_H,    SY_GRID, {0, 0, 0, 0, 0, 0, 0}},
    {OP_GEMM, SY_NONE,  {K_QK,    8, 1024, 1024, 1024, 0, 0}},
    {OP_GEMM, SY_NONE,  {K_TRANS, 4, 1024, 1024, 1024, 0, 0}},
    {OP_GEMM, SY_LOCAL, {K_LOW,   3, 1024, 1024, 1024, 0, 0}},
    {OP_GEMM, SY_NONE,  {K_S,     4, 256,  512,  256,  0, 0}},
    {OP_GEMM, SY_GRID,  {K_U,     4, 256,  512,  256,  0, 0}},
    {OP_SCAN, SY_GRID,  {0, 0, 0, 0, 0, 0, 0}},
    {OP_GEMM, SY_NONE,  {K_MAIN,  4, 512,  512,  512,  0, 0}},
    {OP_GEMM, SY_LOCAL, {K_TRANS, 4, 1024, 1024, 1024, 1, 0}},
    {OP_GEMM, SY_GRID,  {K_U,     4, 256,  512,  256,  1, 0}},
    {OP_SCAN, SY_GRID,  {0, 0, 0, 0, 0, 0, 0}},
    {OP_GEMM, SY_NONE,  {K_MAIN,  4, 512,  512,  512,  1, 0}},
    {OP_GEMM, SY_WAR,   {K_GRET,  8, 1024, 1024, 1024, 0, 0}},
    {OP_GEMM, SY_NONE,  {K_QUP,   6, 384,  384,  384,  0, 0}},
    {OP_GEMM, SY_GRID,  {K_KVUP,  8, 256,  256,  256,  0, 0}},
    {OP_ATTN, SY_AFLAG, {0, 0, 0, 0, 0, 0, 0}},
    {OP_GEMM, SY_NONE,  {K_GMLA,  4, 1024, 1024, 1024, 0, 0}},
    {OP_GEMM, SY_NONE,  {K_P0,    4, 1024, 1024, 1024, 0, 0}},
    {OP_GEMM, SY_PANEL, {K_P2,    4, 1024, 1024, 1024, 0, 1}},
    {OP_GEMM, SY_NONE,  {K_P1,    4, 1024, 1024, 1024, 0, 0}},
    {OP_GEMM, SY_PANEL, {K_P3,    4, 2048, 2048, 2048, 0, 2}},
    {OP_GEMM, SY_NONE,  {K_FINAL, 4, 1024, 1024, 1024, 0, 0}} };
constexpr int NSTEPS = 23;
__device__ __forceinline__ GCall step_call(int si) { return STEPS[si].g; }

constexpr int NPHASES = NSTEPS;
struct Args { const void* in[16]; float* out; unsigned char* ws; int ph_lo, ph_hi; };
__global__ void __launch_bounds__(NTHR, 2) fwd_kernel(Args args) {
    extern __shared__ __attribute__((aligned(16))) unsigned char lds_raw[];
    LAS unsigned char* lds = (LAS unsigned char*)lds_raw;
    Ctx X; X.out = args.out; X.ws = args.ws;
    X.tid = threadIdx.x; X.lane = X.tid & 63; X.wave = __builtin_amdgcn_readfirstlane(X.tid >> 6);
    X.G = gridDim.x; { const int bx = blockIdx.x; X.vcu = (bx % 8) * (X.G / 8) + bx / 8; }
    volatile LAS unsigned* MISC = (volatile LAS unsigned*)(lds + MISC_OFF);
    for (int u = X.tid; u < (LDS_BYTES - LDSCTL_OFF) / 4; u += NTHR) ((LAS unsigned*)(lds + LDSCTL_OFF))[u] = 0u;
    __syncthreads();
    if (X.tid < 16) *(LAS unsigned long long*)(lds + PTR_OFF + 8 * X.tid) = (unsigned long long)args.in[X.tid];
    if (X.tid == 16) *(LAS unsigned long long*)(lds + PTR_OFF + 8 * 16) = (unsigned long long)args.out;
    if (X.tid == 17) *(LAS unsigned long long*)(lds + PTR_OFF + 8 * 17) = (unsigned long long)args.ws;
    __syncthreads();
    gu32* ctl = (gu32*)(X.ws + WS_CTL);
    if (X.tid == 19) __hip_atomic_store((unsigned*)ctl + CW_XCC + X.vcu, xb_xcc_id() + 1u, __ATOMIC_RELAXED, __HIP_MEMORY_SCOPE_AGENT);
    XcdBarrier bar = xcd_barrier_post((unsigned*)(ctl + CW_BAR), MISC + 8);
    const int lo = args.ph_lo, hi = args.ph_hi;
    const Ctx X_ = X;
    for (int si = lo; si < hi; ++si) {
        Ctx X = X_; asm volatile("" : "+v"(X.tid), "+v"(X.lane), "+s"(X.wave), "+s"(X.vcu)); X.out = (float*)inptr_raw(16); X.ws = (unsigned char*)inptr_raw(17);
        const int op = STEPS[si].op, sync = STEPS[si].sync;
        if (op == OP_PREP) phase_prep(X, lds);
        else if (op == OP_H) phase_h(X, lds);
        else if (op == OP_SCAN) phase_scan(X);
        else if (op == OP_ATTN) {
            const int head = X.vcu >> 5, l = X.vcu & 31;
            const bf16_t* Qh = (const bf16_t*)(X.ws + WS_Q) + head * 192; const bf16_t* Kh = (const bf16_t*)(X.ws + WS_K) + head * 192; const bf16_t* Vh = (const bf16_t*)(X.ws + WS_V) + head * 128;
            bf16_t* Oh = (bf16_t*)(X.ws + WS_O) + head * 128;
#pragma unroll 1
            for (int pass = 0; pass < 2; ++pass) att16::attn_unit(Qh, Kh, Vh, Oh, 256 * (pass ? 63 - l : l), (char*)lds_raw, X.tid);
        }
        else if (op == OP_NORM) phase_norm(X);
        int sync_ = sync;
        if (op == OP_GEMM) { int ns = 1; while (si + ns < hi && STEPS[si + ns - 1].sync == SY_NONE && STEPS[si + ns].op == OP_GEMM) ++ns;
            gemm_stream(lds, si, ns, X); si += ns - 1; sync_ = STEPS[si].sync; }
        if (si + 1 < hi) {
            if (sync_ == SY_GRID) { xcd_barrier(bar);
                if (si == 1 && X.tid == 0) {
                    const unsigned* xc = (const unsigned*)(X.ws + WS_CTL) + CW_XCC + (X.vcu & ~24); const unsigned i0_ = __hip_atomic_load(xc, __ATOMIC_RELAXED, __HIP_MEMORY_SCOPE_AGENT);
                    const bool same_ = i0_ != 0u && __hip_atomic_load(xc + 8, __ATOMIC_RELAXED, __HIP_MEMORY_SCOPE_AGENT) == i0_ && __hip_atomic_load(xc + 16, __ATOMIC_RELAXED, __HIP_MEMORY_SCOPE_AGENT) == i0_
                                       && __hip_atomic_load(xc + 24, __ATOMIC_RELAXED, __HIP_MEMORY_SCOPE_AGENT) == i0_;
                    MISC[12] = same_ ? 1u : 0u; }
            }
            else if (sync_ == SY_PANEL) {
                VM_WAIT(); __syncthreads();
                if (X.tid == 0) { unsigned* cp = (unsigned*)(X.ws + WS_CTL) + CW_PANEL + 64 * (8 * (X.vcu >> 5) + (X.vcu & 7));
                    if (MISC[12] == 0u) { __builtin_amdgcn_fence(__ATOMIC_RELEASE, "agent"); } asm volatile("s_waitcnt vmcnt(0)" ::: "memory");
                    __hip_atomic_fetch_add(cp, 1u, __ATOMIC_RELAXED, __HIP_MEMORY_SCOPE_AGENT);
                    const unsigned panel_need = 4u * (unsigned)STEPS[si].g.nk;
                    unsigned sp = 0; while (__hip_atomic_load(cp, __ATOMIC_RELAXED, __HIP_MEMORY_SCOPE_AGENT) < panel_need) { __builtin_amdgcn_s_sleep(4); if (++sp > (1u << 22)) break; }
                    __builtin_amdgcn_fence(__ATOMIC_ACQUIRE, "agent"); asm volatile("s_waitcnt vmcnt(0)" ::: "memory"); }
                __syncthreads(); }
            else if (sync_ == SY_AFLAG) {
                VM_WAIT(); __syncthreads();
                if (X.tid == 0) { unsigned* fl = (unsigned*)(X.ws + WS_CTL) + CW_AFLAG; const int l_ = X.vcu & 31;
                    asm volatile("s_waitcnt vmcnt(0)" ::: "memory");
                    __hip_atomic_fetch_add((unsigned*)(X.ws + WS_CTL) + CW_ADONE, 1u, __ATOMIC_RELAXED, __HIP_MEMORY_SCOPE_AGENT);
                    __hip_atomic_store(fl + (X.vcu >> 5) * 64 + l_, 1u, __ATOMIC_RELAXED, __HIP_MEMORY_SCOPE_AGENT); __hip_atomic_store(fl + (X.vcu >> 5) * 64 + 63 - l_, 1u, __ATOMIC_RELAXED, __HIP_MEMORY_SCOPE_AGENT);
                    const int t_ = 8 * (X.vcu >> 5) + (X.vcu & 7), o_ = (X.vcu & 31) >> 3; const unsigned* f0 = fl + (2 * o_) * 64 + t_;
                    unsigned sp = 0; while ((__hip_atomic_load(f0, __ATOMIC_RELAXED, __HIP_MEMORY_SCOPE_AGENT) & __hip_atomic_load(f0 + 64, __ATOMIC_RELAXED, __HIP_MEMORY_SCOPE_AGENT)) == 0u) { __builtin_amdgcn_s_sleep(4); if (++sp > (1u << 22)) break; }
                    __builtin_amdgcn_fence(__ATOMIC_ACQUIRE, "agent"); asm volatile("s_waitcnt vmcnt(0)" ::: "memory"); }
                __syncthreads(); }
            else if (sync_ == SY_WAR) {
                VM_WAIT(); __syncthreads();
                if (X.tid == 0) { const unsigned* cw = (const unsigned*)(X.ws + WS_CTL) + CW_WAR;
                    unsigned sp = 0; while (__hip_atomic_load(cw, __ATOMIC_RELAXED, __HIP_MEMORY_SCOPE_AGENT) < (unsigned)X.G) { __builtin_amdgcn_s_sleep(4); if (++sp > (1u << 22)) break; }
                    __builtin_amdgcn_fence(__ATOMIC_ACQUIRE, "agent"); asm volatile("s_waitcnt vmcnt(0)" ::: "memory"); }
                __syncthreads(); }
            else if (sync_ == SY_LOCAL) { VM_WAIT(); __syncthreads(); __builtin_amdgcn_fence(__ATOMIC_ACQUIRE, "workgroup"); }
        }
    }
}


extern "C" void kernel_launch(void* const* d_in, const int* in_sizes, int n_in, void* d_out, int out_size, void* d_ws, size_t ws_size, hipStream_t stream) {
    static int grid = 0;
    if (grid == 0) {
        if (n_in != 16 || out_size != SEQ * DM || ws_size < WS_END) { fprintf(stderr, "kernel_launch: unexpected shapes (n_in %d out %d ws %zu)\n", n_in, out_size, ws_size); grid = -1; return; }
        int dev = 0, cus = 0;
        if (hipGetDevice(&dev) != hipSuccess || hipDeviceGetAttribute(&cus, hipDeviceAttributeMultiprocessorCount, dev) != hipSuccess) { grid = -1; return; }
        if (hipFuncSetAttribute((const void*)fwd_kernel, hipFuncAttributeMaxDynamicSharedMemorySize, LDS_BYTES) != hipSuccess) { fprintf(stderr, "kernel_launch: hipFuncSetAttribute failed\n"); grid = -1; return; }
        (void)hipGetLastError();
        grid = cus;
        if (grid != 256) { fprintf(stderr, "kernel_launch: built for 256 CUs, found %d\n", cus); grid = -1; return; }
    }
    if (grid < 0) return;
    (void)in_sizes;
    if (hipMemsetAsync((char*)d_ws + WS_CTL, 0, CTL_ZERO_BYTES, stream) != hipSuccess) return;
    Args a{};
    for (int i = 0; i < 16; ++i) a.in[i] = d_in[i];
    a.out = (float*)d_out; a.ws = (unsigned char*)d_ws; a.ph_lo = 0; a.ph_hi = NPHASES;
    hipLaunchKernelGGL(fwd_kernel, dim3(grid), dim3(NTHR), LDS_BYTES, stream, a);
}
```
